# Optimizing an MI355X kernel written in HIP

```python
import math
import jax
import jax.numpy as jnp
from jax import lax
import numpy as np


D_MODEL = 1024
BATCH = 32
SEQ = 2048
DEPTH = 2

CTX_LEN = 256
GRID_W = 64
NORM_EPS = 1e-6

MLSTM_WIDTH = 512
MLSTM_HEADS = 4
MLSTM_HEAD_DIM = MLSTM_WIDTH // MLSTM_HEADS
MLSTM_CHUNK = 64

RWKV_WIDTH = 512
RWKV_HEAD_DIM = 64
RWKV_HEADS = RWKV_WIDTH // RWKV_HEAD_DIM
RWKV_DECAY_LORA = 64
RWKV_ICLR_LORA = 64
RWKV_LN_EPS = 64e-5

HGRN_WIDTH = 512
HGRN_HEADS = 4
HGRN_CHUNK = 32

HYENA_WIDTH = 512
HYENA_BANDS = 16
HYENA_POS_DIM = 1 + 2 * HYENA_BANDS
HYENA_FILTER_HIDDEN = 64
HYENA_SIN_FREQ = 1.0
HYENA_FAST_DECAY = 0.3
HYENA_SLOW_DECAY = 1.5
HYENA_TARGET = 1e-2
HYENA_MOD_SHIFT = 0.05

EVEN_SPLITS = (MLSTM_WIDTH,) * 5 + (4 * MLSTM_HEADS,) + (RWKV_WIDTH,) * 4 + (2 * RWKV_DECAY_LORA, 2 * RWKV_ICLR_LORA)
EVEN_IN = sum(EVEN_SPLITS)
ODD_SPLITS = (HGRN_WIDTH,) * 5 + (HYENA_WIDTH,) * 4
ODD_IN = sum(ODD_SPLITS)
MIX_WIDTH_EVEN = MLSTM_WIDTH + RWKV_WIDTH
MIX_WIDTH_ODD = HGRN_WIDTH + HYENA_WIDTH

kernel_name = 'hybrid_mlstm_rwkv7_hgrn2_hyena_dit'


def split_cols(u, sizes):
    return jnp.split(u, np.cumsum(sizes)[:-1].tolist(), axis=-1)


def rmsnorm(x, g):
    xf = x.astype(jnp.float32)
    y = xf * lax.rsqrt(jnp.mean(xf * xf, axis=-1, keepdims=True) + NORM_EPS)
    return (y * g.astype(jnp.float32)).astype(x.dtype)


def heads_rmsnorm(y, g, n_heads):
    B, L, W = y.shape
    yh = y.astype(jnp.float32).reshape(B, L, n_heads, W // n_heads)
    yh = yh * lax.rsqrt(jnp.mean(yh * yh, axis=-1, keepdims=True) + NORM_EPS)
    return yh.reshape(B, L, W) * g.astype(jnp.float32)


def heads_layernorm(y, w, b, n_heads, eps):
    B, L, W = y.shape
    yh = y.astype(jnp.float32).reshape(B, L, n_heads, W // n_heads)
    mu = jnp.mean(yh, axis=-1, keepdims=True)
    var = jnp.mean(jnp.square(yh - mu), axis=-1, keepdims=True)
    yh = (yh - mu) * lax.rsqrt(var + eps)
    return yh.reshape(B, L, W) * w.astype(jnp.float32) + b.astype(jnp.float32)


def adaln(cvec, w_mod, b_mod):
    m = jax.nn.silu(cvec) @ w_mod + b_mod
    return jnp.split(m, 3, axis=-1)


def to_heads(u, n_heads):
    B, L, W = u.shape
    return u.reshape(B, L, n_heads, W // n_heads).transpose(0, 2, 1, 3).astype(jnp.float32)


def from_heads(y):
    B, H, L, d = y.shape
    return y.transpose(0, 2, 1, 3).reshape(B, L, H * d)


def to_chunks(a, T):
    B, H, L = a.shape[:3]
    return jnp.moveaxis(a.reshape(B, H, L // T, T, *a.shape[3:]), 2, 0)


def from_chunks(a):
    nc, B, H, T = a.shape[:4]
    return jnp.moveaxis(a, 0, 2).reshape(B, H, nc * T, *a.shape[4:])


def conv3(u, w):
    up = jnp.pad(u, ((0, 0), (1, 1), (0, 0)))
    return up[:, :-2] * w[0] + up[:, 1:-1] * w[1] + up[:, 2:] * w[2]


def token_shift(u, mu):
    up = jnp.pad(u, ((0, 0), (1, 1), (0, 0)))
    return u + mu * (0.5 * (up[:, :-2] + up[:, 2:]) - u)


def raster_to_column(h):
    B, L, D = h.shape
    rows = L // GRID_W
    return h.reshape(B, rows, GRID_W, D).transpose(0, 2, 1, 3).reshape(B, L, D)


def column_to_raster(h):
    B, L, D = h.shape
    rows = L // GRID_W
    return h.reshape(B, GRID_W, rows, D).transpose(0, 2, 1, 3).reshape(B, L, D)


def bidirectional(scan_fn, init, ctx_shared, ctx_dirs, lat_shared, lat_dirs):
    y_ctx, y_lat = 0.0, 0.0
    for d in range(2):
        orient = (lambda a: a) if d == 0 else (lambda a: jnp.flip(a, axis=2))
        yc, state = scan_fn(tuple(orient(a) for a in ctx_shared + ctx_dirs[d]), init)
        yl, _ = scan_fn(tuple(orient(a) for a in lat_shared + lat_dirs[d]), state)
        y_ctx = y_ctx + orient(yc)
        y_lat = y_lat + orient(yl)
    return y_lat, y_ctx


def mlstm_chunk_scan(inputs, state):
    q, k, v, ig, lf = inputs
    B, H, L, d = q.shape
    mask = jnp.tril(jnp.ones((MLSTM_CHUNK, MLSTM_CHUNK), dtype=bool))

    def step(carry, blk):
        C, n, m = carry
        qc, kc, vc, ic, fc = blk
        b = jnp.cumsum(fc, axis=-1)
        logw = jnp.where(mask, b[..., :, None] - b[..., None, :] + ic[..., None, :], -jnp.inf)
        inter = b + m[..., None]
        m_t = jnp.maximum(inter, jnp.max(logw, axis=-1))
        w = jnp.exp(logw - m_t[..., None])
        s = jnp.exp(inter - m_t)
        qk = jnp.einsum('bhtd,bhsd->bhts', qc, kc) * w
        num = s[..., None] * jnp.einsum('bhtd,bhde->bhte', qc, C) + jnp.einsum('bhts,bhse->bhte', qk, vc)
        den = s * jnp.einsum('bhtd,bhd->bht', qc, n) + jnp.sum(qk, axis=-1)
        h = num / jnp.maximum(jnp.abs(den), jnp.exp(-m_t))[..., None]
        m_new = m_t[..., -1]
        g = jnp.exp(b[..., -1:] - b + ic - m_new[..., None])
        decay = jnp.exp(b[..., -1] + m - m_new)
        C = decay[..., None, None] * C + jnp.einsum('bhs,bhsd,bhse->bhde', g, kc, vc)
        n = decay[..., None] * n + jnp.einsum('bhs,bhsd->bhd', g, kc)
        return (C, n, m_new), h

    state, hs = lax.scan(step, state, tuple(to_chunks(a, MLSTM_CHUNK) for a in inputs))
    return from_chunks(hs), state


def rwkv_scan(inputs, S):
    def step(S, xs):
        r, v, kk, w, k, a = xs
        sa = jnp.einsum('bhvk,bhk->bhv', S, -kk)
        S = S * w[:, :, None, :] + sa[..., None] * (kk * a)[:, :, None, :] + v[..., None] * k[:, :, None, :]
        return S, jnp.einsum('bhvk,bhk->bhv', S, r)

    S, ys = lax.scan(step, S, tuple(jnp.moveaxis(t, 2, 0) for t in inputs))
    return jnp.moveaxis(ys, 0, 2), S


def hgrn_chunk_scan(inputs, S):
    mask = jnp.tril(jnp.ones((HGRN_CHUNK, HGRN_CHUNK), dtype=bool))[:, :, None]

    def step(S, blk):
        qc, vc, kc, gc = blk
        b = jnp.cumsum(gc, axis=2)
        o = jnp.einsum('bhtd,bhde->bhte', qc * jnp.exp(b), S)
        pair = jnp.exp(jnp.where(mask, b[:, :, :, None] - b[:, :, None], -jnp.inf))
        A = jnp.einsum('bhtd,bhtsd,bhsd->bhts', qc, pair, kc)
        o = o + jnp.einsum('bhts,bhse->bhte', A, vc)
        b_end = b[:, :, -1]
        S = jnp.exp(b_end)[..., None] * S + jnp.einsum('bhsd,bhse->bhde', kc * jnp.exp(b_end[:, :, None] - b), vc)
        return S, o

    S, os_ = lax.scan(step, S, tuple(to_chunks(a, HGRN_CHUNK) for a in inputs))
    return from_chunks(os_), S


def hyena_filters(L, p):
    f32 = jnp.float32
    pos = jnp.arange(L, dtype=f32)
    t = pos / L
    bands = jnp.linspace(1e-4, HYENA_BANDS - 1, HYENA_BANDS, dtype=f32)
    ang = (2.0 * math.pi / L) * pos[:, None] * bands
    z = jnp.concatenate([t[:, None], jnp.cos(ang), jnp.sin(ang)], axis=-1)
    hid = jnp.sin(HYENA_SIN_FREQ * (z @ p['y_w1'].astype(f32) + p['y_b1'].astype(f32)))
    hid = jnp.sin(HYENA_SIN_FREQ * (hid @ p['y_w2'].astype(f32) + p['y_b2'].astype(f32)))
    filt = (hid @ p['y_w3'].astype(f32)).reshape(L, 2, HYENA_WIDTH)
    max_decay = math.log(HYENA_TARGET) / HYENA_FAST_DECAY
    min_decay = math.log(HYENA_TARGET) / HYENA_SLOW_DECAY
    deltas = jnp.abs(jnp.linspace(min_decay, max_decay, HYENA_WIDTH, dtype=f32))
    window = jnp.exp(-t[:, None] * deltas) + HYENA_MOD_SHIFT
    filt = filt * window[:, None]
    filt = filt / jnp.sum(jnp.abs(filt), axis=(0, 1), keepdims=True)
    return filt[:, 0], filt[:, 1]


def long_conv_bidir(u, h_fwd, h_bwd, bias):
    B, L, C = u.shape
    kern = jnp.concatenate([h_fwd[:1] + h_bwd[:1], h_fwd[1:], jnp.zeros((1, C), jnp.float32),
                            jnp.flip(h_bwd[1:], axis=0)], axis=0)
    uf = u.astype(jnp.float32)
    spec = jnp.fft.rfft(uf, n=2 * L, axis=1) * jnp.fft.rfft(kern, axis=0)[None]
    y = jnp.fft.irfft(spec, n=2 * L, axis=1)[:, :L]
    return y + uf * bias.astype(jnp.float32)


def hyena_branch(v_in, g0, g1, p):
    L = v_in.shape[1]
    s = conv3(jnp.concatenate([v_in, g0, g1], axis=-1), p['y_short_w']) + p['y_short_b']
    v, x0, x1 = jnp.split(s, 3, axis=-1)
    h_fwd, h_bwd = hyena_filters(L, p)
    return x0 * long_conv_bidir(x1 * v, h_fwd, h_bwd, p['y_bias'])


def even_prep(h, p):
    B, L, _ = h.shape
    f32 = jnp.float32
    mq, mk, mv, mo, mz, mg, rr, rk, rv, rz, wd, ad = split_cols(h @ p['w_in'], EVEN_SPLITS)
    q = jax.nn.silu(conv3(mq, p['m_conv_w'][:, :MLSTM_WIDTH]))
    k = jax.nn.silu(conv3(mk, p['m_conv_w'][:, MLSTM_WIDTH:])) * (MLSTM_HEAD_DIM ** -0.5)
    g = (mg + p['m_gate_b']).astype(f32).reshape(B, L, 2, 2, MLSTM_HEADS).transpose(2, 3, 0, 4, 1)
    m_shared = (to_heads(q, MLSTM_HEADS), to_heads(k, MLSTM_HEADS), to_heads(mv, MLSTM_HEADS))
    m_dirs = tuple((g[d, 0], jax.nn.log_sigmoid(g[d, 1])) for d in range(2))
    r = token_shift(rr.astype(f32), p['r_mu'][0])
    kr = token_shift(rk.astype(f32), p['r_mu'][1])
    v = token_shift(rv.astype(f32), p['r_mu'][2])
    kk = to_heads(kr * p['r_k_k'], RWKV_HEADS)
    kk = kk / jnp.maximum(jnp.sqrt(jnp.sum(kk * kk, axis=-1, keepdims=True)), 1e-12)
    wd = jnp.tanh(wd.astype(f32)).reshape(B, L, 2, RWKV_DECAY_LORA)
    w_raw = p['r_w0'] + jnp.einsum('bldr,drc->bldc', wd, p['r_w_up'])
    decay = jnp.exp(-jnp.exp(-jax.nn.softplus(-w_raw) - 0.5))
    ad = ad.astype(f32).reshape(B, L, 2, RWKV_ICLR_LORA)
    a = jax.nn.sigmoid(p['r_a0'] + jnp.einsum('bldr,drc->bldc', ad, p['r_a_up']))
    kt = kr[:, :, None] * (1.0 + (a - 1.0) * p['r_k_a'])
    r_shared = (to_heads(r, RWKV_HEADS), to_heads(v, RWKV_HEADS), kk)
    r_dirs = tuple((to_heads(decay[:, :, d], RWKV_HEADS), to_heads(kt[:, :, d], RWKV_HEADS),
                    to_heads(a[:, :, d], RWKV_HEADS)) for d in range(2))
    coef = jnp.einsum('blhn,bldhn,hn->blh', r.reshape(B, L, RWKV_HEADS, RWKV_HEAD_DIM),
                      kt.reshape(B, L, 2, RWKV_HEADS, RWKV_HEAD_DIM), p['r_r_k'])
    bonus = (coef[..., None] * v.reshape(B, L, RWKV_HEADS, RWKV_HEAD_DIM)).reshape(B, L, RWKV_WIDTH)
    return {'m_shared': m_shared, 'm_dirs': m_dirs, 'mo': mo, 'mz': mz,
            'r_shared': r_shared, 'r_dirs': r_dirs, 'bonus': bonus, 'rz': rz}


def mixer_even(h_lat, h_ctx, p, need_ctx):
    lat = even_prep(h_lat, p)
    ctx = even_prep(h_ctx, p)
    B = h_lat.shape[0]
    f32 = jnp.float32
    m_init = (jnp.zeros((B, MLSTM_HEADS, MLSTM_HEAD_DIM, MLSTM_HEAD_DIM), f32),
              jnp.zeros((B, MLSTM_HEADS, MLSTM_HEAD_DIM), f32),
              jnp.zeros((B, MLSTM_HEADS), f32))
    r_init = jnp.zeros((B, RWKV_HEADS, RWKV_HEAD_DIM, RWKV_HEAD_DIM), f32)
    m_lat, m_ctx = bidirectional(mlstm_chunk_scan, m_init, ctx['m_shared'], ctx['m_dirs'], lat['m_shared'], lat['m_dirs'])
    r_lat, r_ctx = bidirectional(rwkv_scan, r_init, ctx['r_shared'], ctx['r_dirs'], lat['r_shared'], lat['r_dirs'])

    def finish(pre, m_h, r_h, dtype):
        m_y = heads_rmsnorm(from_heads(m_h), p['m_norm_g'], MLSTM_HEADS) * jax.nn.sigmoid(pre['mo']) * jax.nn.silu(pre['mz'])
        r_y = heads_layernorm(from_heads(r_h) + pre['bonus'], p['r_ln_w'], p['r_ln_b'], RWKV_HEADS, RWKV_LN_EPS) * jax.nn.silu(pre['rz'])
        return jnp.concatenate([m_y, r_y], axis=-1).astype(dtype) @ p['w_out']

    y_lat = finish(lat, m_lat, r_lat, h_lat.dtype)
    y_ctx = finish(ctx, m_ctx, r_ctx, h_ctx.dtype) if need_ctx else None
    return y_lat, y_ctx


def odd_prep(h, p, lb):
    gq, gi, gf_fwd, gf_bwd, gz, yv, y0, y1, yz = split_cols(h @ p['w_in'], ODD_SPLITS)

    def forget(ff):
        log_f = jnp.logaddexp(jnp.log(lb), jnp.log1p(-lb) + jax.nn.log_sigmoid(ff.astype(jnp.float32)))
        return (to_heads(-jnp.expm1(log_f), HGRN_HEADS), to_heads(log_f, HGRN_HEADS))

    return {'g_shared': (to_heads(gq, HGRN_HEADS), to_heads(gi, HGRN_HEADS)),
            'g_dirs': (forget(gf_fwd), forget(gf_bwd)), 'gz': gz,
            'yv': yv, 'y0': y0, 'y1': y1, 'yz': yz}


def mixer_odd(h_lat, h_ctx, p, li, need_ctx):
    probs = jax.nn.softmax(p['lb_all'].astype(jnp.float32), axis=0)
    lb = (jnp.cumsum(probs, axis=0) - probs[0])[li]
    lat = odd_prep(h_lat, p, lb)
    ctx = odd_prep(h_ctx, p, lb)
    B = h_lat.shape[0]
    dh = HGRN_WIDTH // HGRN_HEADS
    init = jnp.zeros((B, HGRN_HEADS, dh, dh), jnp.float32)
    g_lat, g_ctx = bidirectional(hgrn_chunk_scan, init, ctx['g_shared'], ctx['g_dirs'], lat['g_shared'], lat['g_dirs'])

    def finish(pre, g_h, dtype):
        g_y = heads_rmsnorm(from_heads(g_h), p['g_norm_g'], HGRN_HEADS) * jax.nn.silu(pre['gz'])
        y_y = hyena_branch(pre['yv'], pre['y0'], pre['y1'], p) * jax.nn.silu(pre['yz'])
        return jnp.concatenate([g_y, y_y], axis=-1).astype(dtype) @ p['w_out']

    y_lat = finish(lat, g_lat, h_lat.dtype)
    y_ctx = finish(ctx, g_ctx, h_ctx.dtype) if need_ctx else None
    return y_lat, y_ctx


def trunk_layer(x, xc, c, c_ctx, li, p, need_ctx):
    shift, scale, gate = adaln(c, p['mod_w'], p['mod_b'])
    c_shift, c_scale, c_gate = adaln(c_ctx, p['mod_w'], p['mod_b'])
    h = rmsnorm(x, p['norm_g']) * (1.0 + scale[:, None]) + shift[:, None]
    hc = rmsnorm(xc, p['norm_g']) * (1.0 + c_scale) + c_shift
    if li % 2 == 0:
        y, yc = mixer_even(h, hc, p, need_ctx)
    else:
        y, yc = mixer_odd(raster_to_column(h), hc, p, li, need_ctx)
        y = column_to_raster(y)
    x = x + gate[:, None] * y
    if need_ctx:
        xc = xc + c_gate * yc
    return x, xc


def setup_inputs(seed: int = 0) -> dict:
    key = jax.random.key(seed)
    keys = jax.random.split(key, 64)
    count = [0]
    f32 = jnp.float32

    def nrm(shape, scale=1.0):
        k = keys[count[0]]
        count[0] += 1
        return scale * jax.random.normal(k, shape, f32)

    D = D_MODEL
    H = HYENA_FILTER_HIDDEN
    ident3 = jnp.array([0.0, 1.0, 0.0], f32)[:, None]
    f_bias = jnp.linspace(3.0, 6.0, MLSTM_HEADS, dtype=f32)
    return {
        'x': nrm((BATCH, SEQ, D)),
        'c': nrm((BATCH, D)),
        'ctx': nrm((BATCH, CTX_LEN, D)),
        'c_ctx': nrm((D,)),
        'l0_norm_g': 1.0 + nrm((D,), 0.02),
        'l0_mod_w': nrm((D, 3 * D), 0.5 * D ** -0.5),
        'l0_mod_b': nrm((3 * D,), 0.01),
        'l0_w_in': nrm((D, EVEN_IN), D ** -0.5),
        'l0_w_out': nrm((MIX_WIDTH_EVEN, D), MIX_WIDTH_EVEN ** -0.5),
        'l0_mlstm_conv_w': ident3 + nrm((3, 2 * MLSTM_WIDTH), 0.2),
        'l0_mlstm_gate_b': jnp.stack([nrm((2, MLSTM_HEADS), 0.1), f_bias + nrm((2, MLSTM_HEADS), 0.1)], axis=1).reshape(-1),
        'l0_mlstm_norm_g': 1.0 + nrm((MLSTM_WIDTH,), 0.02),
        'l0_rwkv_mu': 0.5 + nrm((3, RWKV_WIDTH), 0.1),
        'l0_rwkv_w0': jnp.linspace(-6.5, -1.5, RWKV_WIDTH, dtype=f32)[None] + nrm((2, RWKV_WIDTH), 0.1),
        'l0_rwkv_w_up': nrm((2, RWKV_DECAY_LORA, RWKV_WIDTH), 0.1 * RWKV_DECAY_LORA ** -0.5),
        'l0_rwkv_a0': nrm((2, RWKV_WIDTH), 0.1),
        'l0_rwkv_a_up': nrm((2, RWKV_ICLR_LORA, RWKV_WIDTH), 0.1 * RWKV_ICLR_LORA ** -0.5),
        'l0_rwkv_k_k': 0.85 + nrm((RWKV_WIDTH,), 0.02),
        'l0_rwkv_k_a': 1.0 + nrm((RWKV_WIDTH,), 0.02),
        'l0_rwkv_r_k': nrm((RWKV_HEADS, RWKV_HEAD_DIM), 0.1),
        'l0_rwkv_ln_w': 1.0 + nrm((RWKV_WIDTH,), 0.02),
        'l0_rwkv_ln_b': nrm((RWKV_WIDTH,), 0.01),
        'hgrn_lower_bounds': nrm((DEPTH, HGRN_WIDTH), 0.1),
        'l1_norm_g': 1.0 + nrm((D,), 0.02),
        'l1_mod_w': nrm((D, 3 * D), 0.5 * D ** -0.5),
        'l1_mod_b': nrm((3 * D,), 0.01),
        'l1_w_in': nrm((D, ODD_IN), D ** -0.5),
        'l1_w_out': nrm((MIX_WIDTH_ODD, D), MIX_WIDTH_ODD ** -0.5),
        'l1_hgrn_norm_g': 1.0 + nrm((HGRN_WIDTH,), 0.02),
        'l1_hyena_short_w': ident3 + nrm((3, 3 * HYENA_WIDTH), 0.2),
        'l1_hyena_short_b': nrm((3 * HYENA_WIDTH,), 0.01),
        'l1_hyena_w1': nrm((HYENA_POS_DIM, H), HYENA_POS_DIM ** -0.5),
        'l1_hyena_b1': nrm((H,), 0.1),
        'l1_hyena_w2': nrm((H, H), H ** -0.5),
        'l1_hyena_b2': nrm((H,), 0.1),
        'l1_hyena_w3': nrm((H, 2 * HYENA_WIDTH), H ** -0.5),
        'l1_hyena_bias': nrm((HYENA_WIDTH,), 0.5),
        'final_norm_g': 1.0 + nrm((D,), 0.02),
    }


def reference(x, c, ctx, c_ctx, l0_norm_g, l0_mod_w, l0_mod_b, l0_w_in, l0_w_out,
              l0_mlstm_conv_w, l0_mlstm_gate_b, l0_mlstm_norm_g,
              l0_rwkv_mu, l0_rwkv_w0, l0_rwkv_w_up, l0_rwkv_a0, l0_rwkv_a_up,
              l0_rwkv_k_k, l0_rwkv_k_a, l0_rwkv_r_k, l0_rwkv_ln_w, l0_rwkv_ln_b,
              hgrn_lower_bounds,
              l1_norm_g, l1_mod_w, l1_mod_b, l1_w_in, l1_w_out, l1_hgrn_norm_g,
              l1_hyena_short_w, l1_hyena_short_b, l1_hyena_w1, l1_hyena_b1,
              l1_hyena_w2, l1_hyena_b2, l1_hyena_w3, l1_hyena_bias, final_norm_g):
    even_p = {'norm_g': l0_norm_g, 'mod_w': l0_mod_w, 'mod_b': l0_mod_b, 'w_in': l0_w_in, 'w_out': l0_w_out,
              'm_conv_w': l0_mlstm_conv_w, 'm_gate_b': l0_mlstm_gate_b, 'm_norm_g': l0_mlstm_norm_g,
              'r_mu': l0_rwkv_mu, 'r_w0': l0_rwkv_w0, 'r_w_up': l0_rwkv_w_up, 'r_a0': l0_rwkv_a0,
              'r_a_up': l0_rwkv_a_up, 'r_k_k': l0_rwkv_k_k, 'r_k_a': l0_rwkv_k_a, 'r_r_k': l0_rwkv_r_k,
              'r_ln_w': l0_rwkv_ln_w, 'r_ln_b': l0_rwkv_ln_b}
    odd_p = {'norm_g': l1_norm_g, 'mod_w': l1_mod_w, 'mod_b': l1_mod_b, 'w_in': l1_w_in, 'w_out': l1_w_out,
             'lb_all': hgrn_lower_bounds, 'g_norm_g': l1_hgrn_norm_g,
             'y_short_w': l1_hyena_short_w, 'y_short_b': l1_hyena_short_b,
             'y_w1': l1_hyena_w1, 'y_b1': l1_hyena_b1, 'y_w2': l1_hyena_w2, 'y_b2': l1_hyena_b2,
             'y_w3': l1_hyena_w3, 'y_bias': l1_hyena_bias}
    layer_params = (even_p, odd_p)
    xc = ctx
    for li in range(DEPTH):
        x, xc = trunk_layer(x, xc, c, c_ctx, li, layer_params[li], li < DEPTH - 1)
    return rmsnorm(x, final_norm_g)
```

```cpp
#include <hip/hip_runtime.h>
#include <hip/hip_bf16.h>
#include <hip/hip_cooperative_groups.h>
#include <cstdio>
namespace cg = cooperative_groups;

typedef unsigned short bf16_t;
using bf16x8 = __attribute__((ext_vector_type(8))) short;
using f32x16 = __attribute__((ext_vector_type(16))) float;

#define NLAT 65536
#define NCTX 8192
#define NTOK 73728
#define LDU0 4880
#define LDU1 4608
#define NTHREADS 256
#ifndef PROBE_PHASE
#define PROBE_PHASE -1
#endif
#define PROBE_SUB 1
#define SMEM_BYTES 75776

constexpr size_t MiB = 1ull << 20;
constexpr size_t OFF_WIN0T = 0;
constexpr size_t OFF_WOUT0T = 10 * MiB;
constexpr size_t OFF_WIN1T = 12 * MiB;
constexpr size_t OFF_WOUT1T = 21 * MiB;
constexpr size_t OFF_MOD = 23 * MiB;
constexpr size_t OFF_FILT = 24 * MiB;
constexpr size_t OFF_KERN = 32 * MiB;
constexpr size_t OFF_MISC = 40 * MiB;
constexpr size_t OFF_RH = 41 * MiB;
constexpr size_t OFF_RU = 185 * MiB;
constexpr size_t OFF_CTXOUT = 872 * MiB;
constexpr size_t OFF_XC1 = 904 * MiB;
constexpr size_t OFF_UHY = 833 * MiB;
constexpr size_t OFF_GHY = 897 * MiB;
constexpr size_t WS_NEED = 961 * MiB;

#define C_MQ 0
#define C_MK 512
#define C_MV 1024
#define C_MO 1536
#define C_MZ 2048
#define C_MG 2560
#define C_RR 2576
#define C_RK 3088
#define C_RV 3600
#define C_RZ 4112
#define C_WD 4624
#define C_AD 4752
#define C_GQ 0
#define C_GI 512
#define C_GF 1024
#define C_GZ 2048
#define C_YV 2560
#define C_Y0 3072
#define C_Y1 3584
#define C_YZ 4096

struct Params {
  const float* in[38];
  float* out;
  char* ws;
  int ph_lo, ph_hi;
};

__device__ __forceinline__ bf16_t f2bf(float f) {
  const __bf16 b = (__bf16)f;
  return __builtin_bit_cast(unsigned short, b);
}
__device__ __forceinline__ float bf2f(bf16_t h) { return __uint_as_float(((unsigned)h) << 16); }
__device__ __forceinline__ float frcp_(float x) { return __builtin_amdgcn_rcpf(x); }
__device__ __forceinline__ float sigmoidf_(float x) { return frcp_(1.0f + __expf(-x)); }
__device__ __forceinline__ float siluf_(float x) { return x * frcp_(1.0f + __expf(-x)); }
__device__ __forceinline__ float tanh_fast(float x) { return 1.0f - 2.0f * frcp_(1.0f + __expf(2.0f * x)); }
__device__ __forceinline__ int kswz(int row, int k) { return ((((k >> 6) ^ (row & 7)) << 6) | (k & 63)); }
__device__ __forceinline__ int opaque_tid() { int t = threadIdx.x; asm volatile("" : "+v"(t)); return t; }
template <int CTRL> __device__ __forceinline__ float dpp_mov(float v) {
  return __int_as_float(__builtin_amdgcn_mov_dpp(__float_as_int(v), CTRL, 0xF, 0xF, true));
}
__device__ __forceinline__ float wave_sum(float v) {
  v += dpp_mov<0xB1>(v);
  v += dpp_mov<0x4E>(v);
  v += dpp_mov<0x141>(v);
  v += dpp_mov<0x140>(v);
  const int vi = __float_as_int(v);
  return __int_as_float(__builtin_amdgcn_readlane(vi, 0)) + __int_as_float(__builtin_amdgcn_readlane(vi, 16)) +
         __int_as_float(__builtin_amdgcn_readlane(vi, 32)) + __int_as_float(__builtin_amdgcn_readlane(vi, 48));
}

#define G_LDS 40
template <class Epi>
__device__ __forceinline__ void gemm_tiles(const bf16_t* __restrict__ A1, int lda1, const bf16_t* __restrict__ A2, int lda2,
                           const bf16_t* __restrict__ Bt, int Mtiles, int Ntiles, Epi epi, char* smem, int skip_mt = 1 << 30, int skip_nt = 1 << 30) {
  const int tid = opaque_tid(), lane = tid & 63, wave = tid >> 6, wm = wave >> 1, wn = wave & 1;
  const int lr = tid >> 2, lc = tid & 3;
  const int fr = lane & 31, fh = lane >> 5;
  const int ntiles = Mtiles * Ntiles;
  const bool swz = ((gridDim.x & 7) == 0) && ((Mtiles & 31) == 0);
  const int xcd = blockIdx.x & 7;
  const int nper = swz ? ntiles / 8 : ntiles;
  const int start = swz ? (blockIdx.x >> 3) : blockIdx.x;
  const int step = swz ? (gridDim.x >> 3) : gridDim.x;
  for (int lt = start; lt < nper; lt += step) {
    int mt, nt;
    if (swz) {
      const int g = lt / (4 * Ntiles), within = lt % (4 * Ntiles);
      nt = within >> 2;
      mt = xcd * (Mtiles >> 3) + g * 4 + (within & 3);
    } else { mt = lt / Ntiles; nt = lt % Ntiles; }
    if (mt >= skip_mt && nt >= skip_nt) continue;
    const int row0 = mt * 256, col0 = nt * 128;
    f32x16 acc[4][2];
#pragma unroll
    for (int i = 0; i < 4; ++i)
#pragma unroll
      for (int j = 0; j < 2; ++j)
#pragma unroll
        for (int r = 0; r < 16; ++r) acc[i][j][r] = 0.f;
    const unsigned aoff = (unsigned)(((row0 + lr) * lda1 + lc * 8) * 2);
    const unsigned boff = (unsigned)(((col0 + lr) * 1024 + lc * 8) * 2);
    const unsigned astrb = (unsigned)(64 * lda1 * 2);
    uint4 Pa0, Pa1, Pa2, Pa3, Pb0, Pb1;
#define LD16(base_, off_) (*(const uint4*)((const char*)(base_) + (off_)))
#define G_KOFF(k_) ((unsigned)((((((k_) >> 1) & 7) ^ (lr & 7)) * 128) + ((k_) & 1) * 64))
#define G_LOADX(k_) { const char* ab_ = ((k_) < 16) ? (const char*)A1 : (const char*)A2; const unsigned ko_ = G_KOFF(k_); \
                      const unsigned ao_ = aoff + ko_; const unsigned bo_ = boff + ko_ + (((k_) >= 16) ? 1024u : 0u); \
                      Pa0 = LD16(ab_, ao_); Pa1 = LD16(ab_, ao_ + astrb); Pa2 = LD16(ab_, ao_ + 2 * astrb); Pa3 = LD16(ab_, ao_ + 3 * astrb); \
                      Pb0 = LD16(Bt, bo_); Pb1 = LD16(Bt, bo_ + 131072u); }
#define G_STOREX(stage_) { bf16_t* pa_ = (bf16_t*)smem + (stage_) * (384 * G_LDS) + lr * G_LDS + lc * 8; bf16_t* pb_ = pa_ + 256 * G_LDS; \
                           *(uint4*)(pa_) = Pa0; *(uint4*)(pa_ + 64 * G_LDS) = Pa1; *(uint4*)(pa_ + 128 * G_LDS) = Pa2; *(uint4*)(pa_ + 192 * G_LDS) = Pa3; \
                           *(uint4*)(pb_) = Pb0; *(uint4*)(pb_ + 64 * G_LDS) = Pb1; }
#define G_COMPUTE(stage_) { \
      const bf16_t* As = (const bf16_t*)smem + (stage_) * (384 * G_LDS); \
      const bf16_t* Bs = As + 256 * G_LDS; \
      _Pragma("unroll") for (int s = 0; s < 2; ++s) { \
        bf16x8 a[4], b[2]; \
        _Pragma("unroll") for (int i = 0; i < 4; ++i) a[i] = *(const bf16x8*)(As + (wm * 128 + i * 32 + fr) * G_LDS + s * 16 + fh * 8); \
        _Pragma("unroll") for (int j = 0; j < 2; ++j) b[j] = *(const bf16x8*)(Bs + (wn * 64 + j * 32 + fr) * G_LDS + s * 16 + fh * 8); \
        _Pragma("unroll") for (int i = 0; i < 4; ++i) \
          _Pragma("unroll") for (int j = 0; j < 2; ++j) acc[i][j] = __builtin_amdgcn_mfma_f32_32x32x16_bf16(a[i], b[j], acc[i][j], 0, 0, 0); \
      } \
      asm volatile("s_waitcnt lgkmcnt(0)" ::: "memory"); \
      __builtin_amdgcn_s_barrier(); \
      asm volatile("" ::: "memory"); }
    G_LOADX(0)
    { asm volatile("s_waitcnt lgkmcnt(0)" ::: "memory"); __builtin_amdgcn_s_barrier(); asm volatile("" ::: "memory"); }
    G_STOREX(0)
    G_LOADX(1)
    { asm volatile("s_waitcnt lgkmcnt(0)" ::: "memory"); __builtin_amdgcn_s_barrier(); asm volatile("" ::: "memory"); }
#pragma unroll 2
    for (int kt = 0; kt < 32; ++kt) {
      const int cur = kt & 1;
      if (kt + 1 < 32) G_STOREX(cur ^ 1)
      if (kt + 2 < 32) G_LOADX(kt + 2)
      G_COMPUTE(cur)
    }
    float* Cs = (float*)smem;
#pragma unroll
    for (int hh = 0; hh < 2; ++hh) {
      if (hh) { asm volatile("s_waitcnt lgkmcnt(0)" ::: "memory"); __builtin_amdgcn_s_barrier(); asm volatile("" ::: "memory"); }
      if (wm == hh) {
#pragma unroll
        for (int i = 0; i < 4; ++i)
#pragma unroll
          for (int j = 0; j < 2; ++j)
#pragma unroll
            for (int r = 0; r < 16; ++r) {
              const int row = i * 32 + (r & 3) + 8 * (r >> 2) + 4 * fh;
              const int col = wn * 64 + j * 32 + fr;
              Cs[row * 132 + col] = acc[i][j][r];
            }
      }
      { asm volatile("s_waitcnt lgkmcnt(0)" ::: "memory"); __builtin_amdgcn_s_barrier(); asm volatile("" ::: "memory"); }
#pragma unroll
      for (int it = 0; it < 8; ++it) {
        const int idx = it * 256 + tid;
        const int row = idx >> 4, c8 = (idx & 15) * 8;
        const float4 v0 = *(const float4*)(Cs + row * 132 + c8);
        const float4 v1 = *(const float4*)(Cs + row * 132 + c8 + 4);
        float v[8] = {v0.x, v0.y, v0.z, v0.w, v1.x, v1.y, v1.z, v1.w};
        epi(row0 + hh * 128 + row, col0 + c8, v);
      }
    }
  }
  __syncthreads();
}

__device__ __forceinline__ void st8(bf16_t* ptr, const float* v);

struct EpiStoreBf16 {
  bf16_t* U; int ldu; int N;
  __device__ __forceinline__ void operator()(int row, int col, const float* v) const {
    if (col < N) st8(U + (size_t)row * ldu + col, v);
  }
};
__device__ __forceinline__ void resid8(float* dst, const float* src, const float* gate, const float* v) {
  const float4 x0 = *(const float4*)src, x1 = *(const float4*)(src + 4);
  const float4 g0 = *(const float4*)gate, g1 = *(const float4*)(gate + 4);
  float4 o0, o1;
  o0.x = x0.x + g0.x * v[0]; o0.y = x0.y + g0.y * v[1]; o0.z = x0.z + g0.z * v[2]; o0.w = x0.w + g0.w * v[3];
  o1.x = x1.x + g1.x * v[4]; o1.y = x1.y + g1.y * v[5]; o1.z = x1.z + g1.z * v[6]; o1.w = x1.w + g1.w * v[7];
  *(float4*)dst = o0; *(float4*)(dst + 4) = o1;
}
struct EpiOut0 {
  const float* x; const float* ctx; const float* mod; float* x1; float* xc1;
  __device__ __forceinline__ void operator()(int row, int col, const float* v) const {
    if (row < NLAT) {
      const int b = row >> 11;
      const size_t idx = (size_t)row * 1024 + col;
      resid8(x1 + idx, x + idx, mod + b * 3072 + 2048 + col, v);
    } else {
      const size_t idx = (size_t)(row - NLAT) * 1024 + col;
      resid8(xc1 + idx, ctx + idx, mod + 32 * 3072 + 2048 + col, v);
    }
  }
};
struct EpiOut1 {
  const float* mod; float* x1;
  __device__ __forceinline__ void operator()(int row, int col, const float* v) const {
    const int b = row >> 11, tp = row & 2047;
    const int t = (tp & 31) * 64 + (tp >> 5);
    const size_t idx = ((size_t)b * 2048 + t) * 1024 + col;
    resid8(x1 + idx, x1 + idx, mod + b * 3072 + 2048 + col, v);
  }
};

__device__ __forceinline__ void transpose_item(const float* __restrict__ W, int N, bf16_t* __restrict__ WT, int item, char* smem) {
  float* tile = (float*)smem;
  const int kt = item & 15, ntile = item >> 4;
  const int k0 = kt * 64, n0 = ntile * 64;
  const int tid = opaque_tid();
  __syncthreads();
#pragma unroll
  for (int i = 0; i < 16; ++i) {
    const int k = i * 4 + (tid >> 6), n = tid & 63;
    float v = 0.f;
    if (n0 + n < N) v = W[(size_t)(k0 + k) * N + n0 + n];
    tile[k * 65 + n] = v;
  }
  __syncthreads();
#pragma unroll
  for (int i = 0; i < 16; ++i) {
    const int n = i * 4 + (tid >> 6), k = tid & 63;
    WT[(size_t)(n0 + n) * 1024 + kswz(n0 + n, k0 + k)] = f2bf(tile[k * 65 + n]);
  }
}

__device__ __forceinline__ void adaln_item(const Params& p, int item, char* smem) {
  const int layer = item / 48, cgp = item % 48;
  const float* mod_w = p.in[layer ? 24 : 5];
  const float* mod_b = p.in[layer ? 25 : 6];
  const float* cvec = p.in[1];
  const float* cctx = p.in[3];
  float* mod = (float*)(p.ws + OFF_MOD) + layer * 33 * 3072;
  float* sc = (float*)smem;
  float* red = sc + 33 * 128;
  const int tid = opaque_tid(), kq = tid >> 6, n = tid & 63;
  const int ncol = cgp * 64 + n;
  float acc[33];
#pragma unroll
  for (int r = 0; r < 33; ++r) acc[r] = 0.f;
  for (int kc = 0; kc < 1024; kc += 128) {
    __syncthreads();
    for (int e = tid; e < 33 * 128; e += NTHREADS) {
      const int r = e >> 7, kk = e & 127;
      const float v = (r < 32) ? cvec[r * 1024 + kc + kk] : cctx[kc + kk];
      sc[e] = siluf_(v);
    }
    __syncthreads();
#pragma unroll 2
    for (int kk = kq * 32; kk < kq * 32 + 32; ++kk) {
      const float w = mod_w[(size_t)(kc + kk) * 3072 + ncol];
#pragma unroll
      for (int r = 0; r < 33; ++r) acc[r] += sc[r * 128 + kk] * w;
    }
  }
  __syncthreads();
#pragma unroll
  for (int r = 0; r < 33; ++r) red[(kq * 33 + r) * 64 + n] = acc[r];
  __syncthreads();
  for (int e = tid; e < 33 * 64; e += NTHREADS) {
    const int r = e >> 6, nn = e & 63;
    const float s = red[(0 * 33 + r) * 64 + nn] + red[(1 * 33 + r) * 64 + nn] + red[(2 * 33 + r) * 64 + nn] + red[(3 * 33 + r) * 64 + nn];
    mod[r * 3072 + cgp * 64 + nn] = s + mod_b[cgp * 64 + nn];
  }
}

__device__ __forceinline__ void hyena_filter_item(const Params& p, int item, char* smem) {
  const float* w1 = p.in[31]; const float* b1 = p.in[32];
  const float* w2 = p.in[33]; const float* b2 = p.in[34];
  const float* w3 = p.in[35];
  float* FILT = (float*)(p.ws + OFF_FILT);
  float* z = (float*)smem;
  float* h1 = z + 8 * 36;
  float* h2 = h1 + 8 * 64;
  const int tid = opaque_tid();
  const int pos0 = item * 8;
  __syncthreads();
  for (int e = tid; e < 8 * 33; e += NTHREADS) {
    const int pp = e / 33, i = e % 33;
    const float pos = (float)(pos0 + pp);
    float v;
    if (i == 0) v = pos / 2048.0f;
    else {
      const int bi = (i - 1) & 15;
      const float band = 1e-4f + (float)bi * ((15.0f - 1e-4f) / 15.0f);
      const float ang = (6.283185307179586f / 2048.0f) * pos * band;
      v = (i <= 16) ? cosf(ang) : sinf(ang);
    }
    z[pp * 36 + i] = v;
  }
  __syncthreads();
  for (int e = tid; e < 8 * 64; e += NTHREADS) {
    const int pp = e >> 6, j = e & 63;
    float s = b1[j];
#pragma unroll 1
    for (int i = 0; i < 33; ++i) s += z[pp * 36 + i] * w1[i * 64 + j];
    h1[pp * 64 + j] = sinf(s);
  }
  __syncthreads();
  for (int e = tid; e < 8 * 64; e += NTHREADS) {
    const int pp = e >> 6, j = e & 63;
    float s = b2[j];
#pragma unroll 4
    for (int i = 0; i < 64; ++i) s += h1[pp * 64 + i] * w2[i * 64 + j];
    h2[pp * 64 + j] = sinf(s);
  }
  __syncthreads();
  const float min_decay = -3.0701134573253946f, max_decay = -15.350567286626973f;
#pragma unroll 1
  for (int q = 0; q < 4; ++q) {
    const int cc = q * 256 + tid;
    const int dir = cc >> 9, c = cc & 511;
    float s[8];
#pragma unroll
    for (int pp = 0; pp < 8; ++pp) s[pp] = 0.f;
#pragma unroll 4
    for (int j = 0; j < 64; ++j) {
      const float w = w3[j * 1024 + cc];
#pragma unroll
      for (int pp = 0; pp < 8; ++pp) s[pp] += h2[pp * 64 + j] * w;
    }
    const float delta = fabsf(min_decay + (float)c * ((max_decay - min_decay) / 511.0f));
#pragma unroll
    for (int pp = 0; pp < 8; ++pp) {
      const float t = (float)(pos0 + pp) / 2048.0f;
      const float win = expf(-t * delta) + 0.05f;
      FILT[((size_t)dir * 2048 + pos0 + pp) * 512 + c] = s[pp] * win;
    }
  }
}

__device__ __forceinline__ void phase_setup(const Params& p, char* smem) {
  if (blockIdx.x == 0 && threadIdx.x < 16) ((int*)(p.ws + OFF_MISC + 4096))[threadIdx.x] = 0;
  if (blockIdx.x == 0) { unsigned* bz = (unsigned*)(p.ws + OFF_MISC + 12288); for (int i = threadIdx.x; i < 1024; i += NTHREADS) bz[i] = 0u; }
  for (int item = blockIdx.x; item < 3264; item += gridDim.x) {
    if (item < 1248) transpose_item(p.in[7], 4880, (bf16_t*)(p.ws + OFF_WIN0T), item, smem);
    else if (item < 1504) transpose_item(p.in[8], 1024, (bf16_t*)(p.ws + OFF_WOUT0T), item - 1248, smem);
    else if (item < 2656) transpose_item(p.in[26], 4608, (bf16_t*)(p.ws + OFF_WIN1T), item - 1504, smem);
    else if (item < 2912) transpose_item(p.in[27], 1024, (bf16_t*)(p.ws + OFF_WOUT1T), item - 2656, smem);
    else if (item < 3008) adaln_item(p, item - 2912, smem);
    else hyena_filter_item(p, item - 3008, smem);
  }
}

__device__ __forceinline__ void norm_mod_row(const float* __restrict__ src, const float* __restrict__ g, const float* __restrict__ modrow,
                                             bf16_t* __restrict__ dst, int lane, int row) {
  float4 v[4];
  float ss = 0.f;
#pragma unroll
  for (int i = 0; i < 4; ++i) {
    v[i] = *(const float4*)(src + i * 256 + lane * 4);
    ss += v[i].x * v[i].x + v[i].y * v[i].y + v[i].z * v[i].z + v[i].w * v[i].w;
  }
  ss = wave_sum(ss);
  const float rstd = rsqrtf(ss * (1.0f / 1024.0f) + 1e-6f);
#pragma unroll
  for (int i = 0; i < 4; ++i) {
    const int c = i * 256 + lane * 4;
    const float4 gg = *(const float4*)(g + c);
    const float4 sh = *(const float4*)(modrow + c);
    const float4 sc = *(const float4*)(modrow + 1024 + c);
    const float o0 = v[i].x * rstd * gg.x * (1.0f + sc.x) + sh.x;
    const float o1 = v[i].y * rstd * gg.y * (1.0f + sc.y) + sh.y;
    const float o2 = v[i].z * rstd * gg.z * (1.0f + sc.z) + sh.z;
    const float o3 = v[i].w * rstd * gg.w * (1.0f + sc.w) + sh.w;
    uint2 pk;
    pk.x = (unsigned)f2bf(o0) | ((unsigned)f2bf(o1) << 16);
    pk.y = (unsigned)f2bf(o2) | ((unsigned)f2bf(o3) << 16);
    *(uint2*)(dst + kswz(row, c)) = pk;
  }
}

__device__ __forceinline__ void phase_h(const Params& p, int layer) {
  const int lane = threadIdx.x & 63, wave = threadIdx.x >> 6;
  const float* g = p.in[layer ? 23 : 4];
  const float* mod = (const float*)(p.ws + OFF_MOD) + layer * 33 * 3072;
  bf16_t* hbuf = (bf16_t*)(p.ws + OFF_RH);
  const float* xc1 = (const float*)(p.ws + OFF_XC1);
  for (int row = blockIdx.x * 4 + wave; row < NTOK; row += gridDim.x * 4) {
    const float* src; const float* modrow;
    if (row < NLAT) {
      const int b = row >> 11;
      modrow = mod + b * 3072;
      if (layer == 0) src = p.in[0] + (size_t)row * 1024;
      else {
        const int tp = row & 2047;
        const int t = (tp & 31) * 64 + (tp >> 5);
        src = p.out + ((size_t)b * 2048 + t) * 1024;
      }
    } else {
      modrow = mod + 32 * 3072;
      src = (layer == 0 ? p.in[2] : xc1) + (size_t)(row - NLAT) * 1024;
    }
    norm_mod_row(src, g, modrow, hbuf + (size_t)row * 1024, lane, row);
  }
}

__device__ __forceinline__ void phase_fnorm(const Params& p, char* smem) {
  const float* FILT = (const float*)(p.ws + OFF_FILT);
  float* fnorm = (float*)(p.ws + OFF_MISC);
  float* red = (float*)smem;
  const int tid = opaque_tid(), ci = tid & 7, ps = tid >> 3;
  for (int item = blockIdx.x; item < 64; item += gridDim.x) {
    const int c = item * 8 + ci;
    float s = 0.f;
    for (int q = ps; q < 4096; q += 32) s += fabsf(FILT[(size_t)q * 512 + c]);
    __syncthreads();
    red[ps * 8 + ci] = s;
    __syncthreads();
    if (tid < 8) {
      float t = 0.f;
      for (int i = 0; i < 32; ++i) t += red[i * 8 + tid];
      fnorm[item * 8 + tid] = t;
    }
  }
}

__device__ __forceinline__ void phase_kern(const Params& p) {
  const float* FILT = (const float*)(p.ws + OFF_FILT);
  const float* fnorm = (const float*)(p.ws + OFF_MISC);
  float* KERNT = (float*)(p.ws + OFF_KERN);
  for (int e = blockIdx.x * NTHREADS + threadIdx.x; e < 4096 * 512; e += gridDim.x * NTHREADS) {
    const int c = e >> 12, mi = e & 4095;
    const int m = mi - 2048;
    float v;
    if (mi == 0) v = 0.f;
    else if (m > 0) v = FILT[(size_t)m * 512 + c];
    else if (m < 0) v = FILT[((size_t)2048 + (-m)) * 512 + c];
    else v = FILT[c] + FILT[(size_t)2048 * 512 + c];
    KERNT[e] = v / fnorm[c];
  }
}

__device__ __forceinline__ bf16_t* out0_ptr(const Params& p, int branch, int dir, int row) {
  const int idx = branch * 2 + dir;
  if (row < NLAT) return (bf16_t*)((char*)p.out + (size_t)idx * 64 * MiB) + (size_t)row * 512;
  return (bf16_t*)(p.ws + OFF_CTXOUT + (size_t)idx * 8 * MiB) + (size_t)(row - NLAT) * 512;
}

using f32x4v = __attribute__((ext_vector_type(4))) float;
using bf16x4 = __attribute__((ext_vector_type(4))) short;
__device__ __forceinline__ bf16x8 pack8(const f32x16& a, int s2) {
  bf16x8 r;
#pragma unroll
  for (int j = 0; j < 8; ++j) r[j] = (short)f2bf(a[8 * s2 + j]);
  return r;
}
#define ML_QS 136
#define ML_TS 72
__device__ __forceinline__ void mlstm_chain(const Params& p, int chain, char* smem) {
  const int dir = chain & 1, h = (chain >> 1) & 3, b = chain >> 3;
  const bf16_t* U = (const bf16_t*)(p.ws + OFF_RU);
  const float* convw = p.in[9];
  const float* gate_b = p.in[10];
  bf16_t* Qs = (bf16_t*)smem;
  bf16_t* Ks = Qs + 64 * ML_QS;
  bf16_t* Ps = Ks;
  bf16_t* KgT = Ks + 64 * ML_QS;
  bf16_t* VT = KgT + 128 * ML_TS;
  float* sm = (float*)(VT + 128 * ML_TS);
  float* bcum = sm;
  float* eb = sm + 64;
  float* av = sm + 128;
  float* gs = sm + 192;
  float* denp = sm + 256;
  float* qnp = sm + 384;
  float* deni = sm + 640;
  float* nvec = sm + 704;
  float* scal = sm + 832;
  const int tid = opaque_tid(), lane = tid & 63, w = tid >> 6;
  const int fr = lane & 31, fh = lane >> 5;
  const int si = w >> 1, ti = w & 1;
  const int cc = tid & 127, which = tid >> 7;
  f32x16 Ct[4];
#pragma unroll
  for (int i = 0; i < 4; ++i)
#pragma unroll
    for (int r = 0; r < 16; ++r) Ct[i][r] = 0.f;
  __syncthreads();
  if (tid < 128) nvec[tid] = 0.f;
  const int ccol = (which == 0 ? C_MQ : C_MK) + h * 128 + cc;
  const float cw0 = convw[0 * 1024 + which * 512 + h * 128 + cc];
  const float cw1 = convw[1 * 1024 + which * 512 + h * 128 + cc];
  const float cw2 = convw[2 * 1024 + which * 512 + h * 128 + cc];
  const float kscale = (which == 0) ? 1.0f : 0.08838834764831845f;
  const float gbi = gate_b[dir * 8 + h], gbf = gate_b[dir * 8 + 4 + h];
  for (int seg = 0; seg < 2; ++seg) {
    const int L = seg ? 2048 : 256;
    const int rowbase = seg ? b * 2048 : NLAT + b * 256;
    for (int s0 = 0; s0 < L; s0 += 64) {
      const int tlo = dir ? (L - 64 - s0) : s0;
      if (w == 0) {
        const int t = tlo + (dir ? 63 - lane : lane);
        const size_t rb = (size_t)(rowbase + t) * LDU0 + C_MG + dir * 8 + h;
        const float ig = bf2f(U[rb]) + gbi;
        const float fg = bf2f(U[rb + 4]) + gbf;
        const float lf = -(fmaxf(-fg, 0.f) + __logf(1.0f + __expf(-fabsf(fg))));
        float bc = lf;
#pragma unroll
        for (int o = 1; o < 64; o <<= 1) {
          const float up = __shfl_up(bc, o, 64);
          if (lane >= o) bc += up;
        }
        const float bT = __shfl(bc, 63, 64);
        bcum[lane] = bc;
        eb[lane] = __expf(bc);
        av[lane] = ig - bc;
        gs[lane] = __expf(bT - bc + ig);
        if (lane == 0) scal[0] = __expf(bT);
      }
      __syncthreads();
      {
#pragma unroll 1
        for (int i0 = 0; i0 < 64; i0 += 8) {
          bf16_t xr[10];
#pragma unroll
          for (int r = 0; r < 10; ++r) {
            const int t = tlo + i0 - 1 + r;
            const int tc = min(max(t, 0), L - 1);
            xr[r] = U[(size_t)(rowbase + tc) * LDU0 + ccol];
          }
#pragma unroll
          for (int r = 0; r < 8; ++r) {
            const int i = i0 + r;
            const float xm = (tlo + i - 1 < 0) ? 0.f : bf2f(xr[r]);
            const float x0 = bf2f(xr[r + 1]);
            const float xp = (tlo + i + 1 >= L) ? 0.f : bf2f(xr[r + 2]);
            const float cv = cw0 * xm + cw1 * x0 + cw2 * xp;
            const float val = siluf_(cv) * kscale;
            const int li = dir ? 63 - i : i;
            if (which == 0) Qs[li * ML_QS + cc] = f2bf(val);
            else { Ks[li * ML_QS + cc] = f2bf(val); KgT[cc * ML_TS + li] = f2bf(val * gs[li]); }
          }
        }
#pragma unroll 1
        for (int q0 = 0; q0 < 32; q0 += 16) {
          bf16_t vr[16];
#pragma unroll
          for (int r = 0; r < 16; ++r) vr[r] = U[(size_t)(rowbase + tlo + which * 32 + q0 + r) * LDU0 + C_MV + h * 128 + cc];
#pragma unroll
          for (int r = 0; r < 16; ++r) {
            const int i = which * 32 + q0 + r;
            const int li = dir ? 63 - i : i;
            VT[cc * ML_TS + li] = vr[r];
          }
        }
      }
      __syncthreads();
      f32x16 sacc;
#pragma unroll
      for (int r = 0; r < 16; ++r) sacc[r] = 0.f;
      if (si <= ti) {
#pragma unroll
        for (int ks = 0; ks < 8; ++ks) {
          const bf16x8 a = *(const bf16x8*)(Ks + (si * 32 + fr) * ML_QS + ks * 16 + fh * 8);
          const bf16x8 bq = *(const bf16x8*)(Qs + (ti * 32 + fr) * ML_QS + ks * 16 + fh * 8);
          sacc = __builtin_amdgcn_mfma_f32_32x32x16_bf16(a, bq, sacc, 0, 0, 0);
        }
      }
      float dpart = 0.f;
      {
        const int t = ti * 32 + fr;
        const float bt = bcum[t];
#pragma unroll
        for (int r = 0; r < 16; ++r) {
          const int s_ = si * 32 + (r & 3) + 8 * (r >> 2) + 4 * fh;
          const float wgt = (s_ <= t && si <= ti) ? __expf(bt + av[s_]) : 0.f;
          sacc[r] *= wgt;
          dpart += sacc[r];
        }
        dpart += __shfl_xor(dpart, 32, 64);
      }
      {
        const int t = tid & 63, part = tid >> 6;
        float sq = 0.f;
#pragma unroll 8
        for (int d = part * 32; d < part * 32 + 32; ++d) sq = fmaf(bf2f(Qs[t * ML_QS + d]), nvec[d], sq);
        qnp[part * 64 + t] = sq;
      }
      __syncthreads();
      {
        const int t = ti * 32 + fr;
        if (si <= ti) {
#pragma unroll
          for (int g4 = 0; g4 < 4; ++g4) {
            uint2 pk;
            pk.x = (unsigned)f2bf(sacc[4 * g4 + 0]) | ((unsigned)f2bf(sacc[4 * g4 + 1]) << 16);
            pk.y = (unsigned)f2bf(sacc[4 * g4 + 2]) | ((unsigned)f2bf(sacc[4 * g4 + 3]) << 16);
            *(uint2*)(Ps + t * ML_TS + si * 32 + 8 * g4 + 4 * fh) = pk;
          }
        }
        if (fh == 0) denp[si * 64 + t] = dpart;
        if (si == 1 && fh == 1) denp[64 + fr] = 0.f;
      }
      const float ebT = scal[0];
      if (tid < 128) {
        float sn = 0.f;
#pragma unroll 8
        for (int s_ = 0; s_ < 64; ++s_) sn += bf2f(KgT[tid * ML_TS + s_]);
        nvec[tid] = ebT * nvec[tid] + sn;
      } else if (tid < 192) {
        const int t = tid - 128;
        deni[t] = eb[t] * (qnp[t] + qnp[64 + t] + qnp[128 + t] + qnp[192 + t]);
      }
      __syncthreads();
      if (tid < 64) {
        const float den = denp[tid] + denp[64 + tid] + deni[tid];
        qnp[tid] = 1.0f / fmaxf(fabsf(den), 1.0f);
      }
      __syncthreads();
      bf16_t* obase = (seg ? (bf16_t*)((char*)p.out + (size_t)dir * 64 * MiB) + (size_t)b * 2048 * 512
                           : (bf16_t*)(p.ws + OFF_CTXOUT + (size_t)dir * 8 * MiB) + (size_t)b * 256 * 512) + h * 128 + w * 32;
#pragma unroll 1
      for (int t2 = 0; t2 < 2; ++t2) {
        f32x16 num;
#pragma unroll
        for (int r = 0; r < 16; ++r) num[r] = 0.f;
#pragma unroll
        for (int di = 0; di < 4; ++di)
#pragma unroll
          for (int s2 = 0; s2 < 2; ++s2) {
            const int d0 = di * 32 + 16 * s2;
            const bf16x4 qa = *(const bf16x4*)(Qs + (t2 * 32 + fr) * ML_QS + d0 + 4 * fh);
            const bf16x4 qb = *(const bf16x4*)(Qs + (t2 * 32 + fr) * ML_QS + d0 + 8 + 4 * fh);
            bf16x8 a;
            a[0] = qa[0]; a[1] = qa[1]; a[2] = qa[2]; a[3] = qa[3];
            a[4] = qb[0]; a[5] = qb[1]; a[6] = qb[2]; a[7] = qb[3];
            num = __builtin_amdgcn_mfma_f32_32x32x16_bf16(a, pack8(Ct[di], s2), num, 0, 0, 0);
            __builtin_amdgcn_sched_barrier(0);
          }
#pragma unroll
        for (int r = 0; r < 16; ++r) num[r] *= eb[t2 * 32 + (r & 3) + 8 * (r >> 2) + 4 * fh];
        const int nks = 2 * (t2 + 1);
        for (int ks = 0; ks < nks; ++ks) {
          const bf16x8 a = *(const bf16x8*)(Ps + (t2 * 32 + fr) * ML_TS + ks * 16 + fh * 8);
          const bf16x8 bv = *(const bf16x8*)(VT + (w * 32 + fr) * ML_TS + ks * 16 + fh * 8);
          num = __builtin_amdgcn_mfma_f32_32x32x16_bf16(a, bv, num, 0, 0, 0);
        }
#pragma unroll
        for (int r = 0; r < 16; ++r) {
          const int t = t2 * 32 + (r & 3) + 8 * (r >> 2) + 4 * fh;
          const float hv = num[r] * qnp[t];
          const int tok = tlo + (dir ? 63 - t : t);
          obase[(unsigned)(tok * 512 + fr)] = f2bf(hv);
        }
      }
#pragma unroll
      for (int di = 0; di < 4; ++di) {
#pragma unroll
        for (int r = 0; r < 16; ++r) Ct[di][r] *= ebT;
#pragma unroll
        for (int ks = 0; ks < 4; ++ks) {
          const bf16x8 a = *(const bf16x8*)(KgT + (di * 32 + fr) * ML_TS + ks * 16 + fh * 8);
          const bf16x8 bv = *(const bf16x8*)(VT + (w * 32 + fr) * ML_TS + ks * 16 + fh * 8);
          Ct[di] = __builtin_amdgcn_mfma_f32_32x32x16_bf16(a, bv, Ct[di], 0, 0, 0);
        }
        __builtin_amdgcn_sched_barrier(0);
      }
      __syncthreads();
    }
  }
}

#define RW_LBAR() { asm volatile("s_waitcnt lgkmcnt(0)" ::: "memory"); __builtin_amdgcn_s_barrier(); asm volatile("" ::: "memory"); }
__device__ __forceinline__ bf16x8 cat44(bf16x4 lo, bf16x4 hi) {
  bf16x8 r;
  r[0] = lo[0]; r[1] = lo[1]; r[2] = lo[2]; r[3] = lo[3]; r[4] = hi[0]; r[5] = hi[1]; r[6] = hi[2]; r[7] = hi[3];
  return r;
}
__device__ __forceinline__ bf16x8 pk4z(const f32x4v& a) {
  bf16x8 r;
  r[0] = (short)f2bf(a[0]); r[1] = (short)f2bf(a[1]); r[2] = (short)f2bf(a[2]); r[3] = (short)f2bf(a[3]);
  r[4] = 0; r[5] = 0; r[6] = 0; r[7] = 0;
  return r;
}
__device__ __forceinline__ void rwkv_chain(const Params& p, int chain, char* smem) {
  const int dir = chain & 1, h = (chain >> 1) & 7, b = chain >> 4;
  const bf16_t* U = (const bf16_t*)(p.ws + OFF_RU);
  bf16_t* RAWb = (bf16_t*)smem;
  bf16_t* TW = RAWb + 18 * 320;
  bf16_t* ADi = TW + 16 * 72;
  bf16_t* WupT = ADi + 16 * 72;
  bf16_t* AupT = WupT + 64 * 72;
  bf16_t* At = AupT + 64 * 72;
  bf16_t* Bt = At + 16 * 72;
  bf16_t* Kt = Bt + 16 * 72;
  bf16_t* Rt = Kt + 16 * 72;
  bf16_t* BKh = Rt + 16 * 72;
  bf16_t* UT = BKh + 64 * 40;
  bf16_t* LakI = UT + 64 * 40;
  bf16_t* MrbI = LakI + 16 * 40;
  bf16_t* MrkI = MrbI + 16 * 40;
  bf16_t* TinvI = MrkI + 16 * 40;
  float* Wd = (float*)(TinvI + 16 * 40);
  float* Av = Wd + 1024;
  float* Vf = Av + 1024;
  float* Lab = Vf + 1024;
  float* COEF = Lab + 272;
  float* WTs = COEF + 16;
  const int tid = opaque_tid(), lane = tid & 63, w = tid >> 6;
  const int c16 = lane & 15, q4 = lane >> 4;
  const int j = tid & 63, tg = tid >> 6;
  const int hj = h * 64 + j;
  const int jw = h * 64 + 16 * w + c16;
  __syncthreads();
  for (int e = tid; e < 64 * 40; e += NTHREADS) UT[e] = 0;
  for (int e = tid; e < 4 * 16 * 40; e += NTHREADS) LakI[e] = 0;
  for (int e = tid; e < 4096; e += NTHREADS) {
    const int r = e >> 6, jj = e & 63;
    WupT[jj * 72 + r] = f2bf(p.in[14][((size_t)dir * 64 + r) * 512 + h * 64 + jj]);
    AupT[jj * 72 + r] = f2bf(p.in[16][((size_t)dir * 64 + r) * 512 + h * 64 + jj]);
  }
  const float mu0 = p.in[12][hj], mu1 = p.in[12][512 + hj], mu2 = p.in[12][1024 + hj];
  const float k_k = p.in[17][hj], k_a = p.in[18][hj], r_k = p.in[19][hj];
  const float w0 = p.in[13][dir * 512 + jw], a0 = p.in[15][dir * 512 + jw];
  f32x4v STt[4];
#pragma unroll
  for (int i = 0; i < 4; ++i) { STt[i][0] = 0.f; STt[i][1] = 0.f; STt[i][2] = 0.f; STt[i][3] = 0.f; }
  uint4 PF[3];
#define RWC_PREFETCH(ci_) { \
    const int seg_ = (ci_) >= 16; const int L_ = seg_ ? 2048 : 256; \
    const int rb_ = seg_ ? b * 2048 : NLAT + b * 256; \
    const int s0_ = (seg_ ? (ci_) - 16 : (ci_)) * 16; \
    const int tl_ = dir ? (L_ - 16 - s0_) : s0_; \
    _Pragma("unroll") for (int q = 0; q < 3; ++q) { \
      const int cid = min(tid + 256 * q, 719); \
      const int row = cid / 40, cc = cid - row * 40; \
      const int arr = cc >> 3, part = cc & 7; \
      const int t_ = tl_ - 1 + row; \
      const int tc_ = min(max(t_, 0), L_ - 1); \
      const int col = ((arr == 0) ? (C_RR + h * 64) : (arr == 1) ? (C_RK + h * 64) : (arr == 2) ? (C_RV + h * 64) : (arr == 3) ? (C_WD + dir * 64) : (C_AD + dir * 64)) + part * 8; \
      uint4 v_ = *(const uint4*)(U + (size_t)(rb_ + tc_) * LDU0 + col); \
      if (t_ < 0 || t_ >= L_) v_ = make_uint4(0u, 0u, 0u, 0u); \
      PF[q] = v_; \
    } }
  RWC_PREFETCH(0)
  for (int ci = 0; ci < 144; ++ci) {
    const int seg = ci >= 16;
    const int L = seg ? 2048 : 256;
    const int s0 = (seg ? ci - 16 : ci) * 16;
    const int tlo = dir ? (L - 16 - s0) : s0;
#pragma unroll
    for (int q = 0; q < 3; ++q) {
      const int cid = tid + 256 * q;
      if (cid < 720) {
        const int row = cid / 40, cc = cid - row * 40;
        *(uint4*)(RAWb + row * 320 + cc * 8) = PF[q];
      }
    }
    RW_LBAR()
    if (ci + 1 < 144) RWC_PREFETCH(ci + 1)
    {
      const int li = tid >> 4, r4 = tid & 15;
      const int itok = dir ? 15 - li : li;
      const bf16x4 wv = *(const bf16x4*)(RAWb + (itok + 1) * 320 + 3 * 64 + r4 * 4);
      const bf16x4 avv = *(const bf16x4*)(RAWb + (itok + 1) * 320 + 4 * 64 + r4 * 4);
      bf16x4 tw;
#pragma unroll
      for (int i = 0; i < 4; ++i) tw[i] = (short)f2bf(tanh_fast(bf2f((bf16_t)wv[i])));
      *(bf16x4*)(TW + li * 72 + r4 * 4) = tw;
      *(bf16x4*)(ADi + li * 72 + r4 * 4) = avv;
    }
    RW_LBAR()
    {
      f32x4v accw = {0.f, 0.f, 0.f, 0.f}, acca = {0.f, 0.f, 0.f, 0.f};
#pragma unroll
      for (int ks = 0; ks < 2; ++ks) {
        const bf16x8 a1 = *(const bf16x8*)(TW + c16 * 72 + ks * 32 + q4 * 8);
        const bf16x8 bw = *(const bf16x8*)(WupT + (16 * w + c16) * 72 + ks * 32 + q4 * 8);
        accw = __builtin_amdgcn_mfma_f32_16x16x32_bf16(a1, bw, accw, 0, 0, 0);
        const bf16x8 a2 = *(const bf16x8*)(ADi + c16 * 72 + ks * 32 + q4 * 8);
        const bf16x8 ba = *(const bf16x8*)(AupT + (16 * w + c16) * 72 + ks * 32 + q4 * 8);
        acca = __builtin_amdgcn_mfma_f32_16x16x32_bf16(a2, ba, acca, 0, 0, 0);
      }
      float cp[4];
#pragma unroll
      for (int r = 0; r < 4; ++r) {
        const int li = 4 * q4 + r;
        const float xw = -(w0 + accw[r]);
        const float sp = fmaxf(xw, 0.f) + __logf(1.0f + __expf(-fabsf(xw)));
        const float dcy = __expf(-__expf(-sp - 0.5f));
        cp[r] = (r == 0) ? dcy : cp[r - 1] * dcy;
        Av[li * 64 + 16 * w + c16] = sigmoidf_(a0 + acca[r]);
      }
      const float t1 = __shfl_up(cp[3], 16, 64), t2 = __shfl_up(cp[3], 32, 64), t3 = __shfl_up(cp[3], 48, 64);
      const float pre = ((q4 >= 1) ? t1 : 1.0f) * ((q4 >= 2) ? t2 : 1.0f) * ((q4 >= 3) ? t3 : 1.0f);
#pragma unroll
      for (int r = 0; r < 4; ++r) Wd[(4 * q4 + r) * 64 + 16 * w + c16] = pre * cp[r];
      if (q4 == 3) WTs[16 * w + c16] = pre * cp[3];
    }
    RW_LBAR()
    {
      const float WTj = WTs[j];
#pragma unroll
      for (int i = 0; i < 4; ++i) {
        const int li = tg * 4 + i;
        const int itok = dir ? 15 - li : li;
        const bf16_t* rp = RAWb + itok * 320;
        const bf16_t* rc = rp + 320;
        const bf16_t* rn = rc + 320;
        const float rrc = bf2f(rc[j]), krc = bf2f(rc[64 + j]), vvc = bf2f(rc[128 + j]);
        const float rr = rrc + mu0 * (0.5f * (bf2f(rp[j]) + bf2f(rn[j])) - rrc);
        const float kr = krc + mu1 * (0.5f * (bf2f(rp[64 + j]) + bf2f(rn[64 + j])) - krc);
        const float vv = vvc + mu2 * (0.5f * (bf2f(rp[128 + j]) + bf2f(rn[128 + j])) - vvc);
        const float av = Av[li * 64 + j];
        const float kkraw = kr * k_k;
        const float ss = wave_sum(kkraw * kkraw);
        const float kk = kkraw * __builtin_amdgcn_rsqf(fmaxf(ss, 1e-24f));
        const float kt = kr * (1.0f + (av - 1.0f) * k_a);
        const float coef = wave_sum(rr * kt * r_k);
        const float bv = kk * av;
        const float Wc = Wd[li * 64 + j];
        const float Wp = (li > 0) ? Wd[(li - 1) * 64 + j] : 1.0f;
        const float iW = frcp_(Wc);
        At[li * 72 + j] = f2bf(-kk * Wp);
        Bt[li * 72 + j] = f2bf(bv * iW);
        Kt[li * 72 + j] = f2bf(kt * iW);
        Rt[li * 72 + j] = f2bf(rr * Wc);
        BKh[j * 40 + li] = f2bf(bv * iW * WTj);
        BKh[j * 40 + 16 + li] = f2bf(kt * iW * WTj);
        UT[j * 40 + li] = f2bf(vv);
        Vf[li * 64 + j] = vv;
        if (j == 0) COEF[li] = coef;
      }
    }
    RW_LBAR()
    {
      const bf16_t* X = (w < 2) ? At : Rt;
      const bf16_t* Yt = (w & 1) ? Kt : Bt;
      f32x4v acc = {0.f, 0.f, 0.f, 0.f};
#pragma unroll
      for (int ks = 0; ks < 2; ++ks) {
        const bf16x8 a = *(const bf16x8*)(X + c16 * 72 + ks * 32 + q4 * 8);
        const bf16x8 bb = *(const bf16x8*)(Yt + c16 * 72 + ks * 32 + q4 * 8);
        acc = __builtin_amdgcn_mfma_f32_16x16x32_bf16(a, bb, acc, 0, 0, 0);
      }
      bf16_t* img = (w == 1) ? LakI : (w == 2) ? MrbI : MrkI;
#pragma unroll
      for (int r = 0; r < 4; ++r) {
        const int t = 4 * q4 + r, s_ = c16;
        const bool keep = (w < 2) ? (s_ < t) : (s_ <= t);
        const float val = keep ? acc[r] : 0.f;
        if (w == 0) Lab[t * 17 + s_] = val;
        else img[t * 40 + s_] = f2bf(val);
      }
    }
    RW_LBAR()
    if (w == 0) {
      float x[16];
#pragma unroll
      for (int t = 0; t < 16; ++t) {
        float sx = (t == c16) ? 1.0f : 0.f;
#pragma unroll
        for (int s_ = 0; s_ < t; ++s_) sx = fmaf(Lab[t * 17 + s_], x[s_], sx);
        x[t] = sx;
      }
      if (q4 == 0) {
#pragma unroll
        for (int t = 0; t < 16; ++t) TinvI[t * 40 + c16] = f2bf(x[t]);
      }
    }
    bf16x8 stB[2];
#pragma unroll
    for (int s2 = 0; s2 < 2; ++s2)
#pragma unroll
      for (int i = 0; i < 4; ++i) { stB[s2][i] = (short)f2bf(STt[2 * s2][i]); stB[s2][4 + i] = (short)f2bf(STt[2 * s2 + 1][i]); }
    const bf16x8 ufrag = *(const bf16x8*)(UT + (16 * w + c16) * 40 + 8 * q4);
    f32x4v rhs = {0.f, 0.f, 0.f, 0.f}, y = {0.f, 0.f, 0.f, 0.f};
#pragma unroll
    for (int s2 = 0; s2 < 2; ++s2) {
      const bf16x8 aa = cat44(*(const bf16x4*)(At + c16 * 72 + 32 * s2 + 4 * q4), *(const bf16x4*)(At + c16 * 72 + 32 * s2 + 16 + 4 * q4));
      rhs = __builtin_amdgcn_mfma_f32_16x16x32_bf16(aa, stB[s2], rhs, 0, 0, 0);
      const bf16x8 ra = cat44(*(const bf16x4*)(Rt + c16 * 72 + 32 * s2 + 4 * q4), *(const bf16x4*)(Rt + c16 * 72 + 32 * s2 + 16 + 4 * q4));
      y = __builtin_amdgcn_mfma_f32_16x16x32_bf16(ra, stB[s2], y, 0, 0, 0);
    }
    rhs = __builtin_amdgcn_mfma_f32_16x16x32_bf16(*(const bf16x8*)(LakI + c16 * 40 + 8 * q4), ufrag, rhs, 0, 0, 0);
    y = __builtin_amdgcn_mfma_f32_16x16x32_bf16(*(const bf16x8*)(MrkI + c16 * 40 + 8 * q4), ufrag, y, 0, 0, 0);
    RW_LBAR()
    {
      const bf16x4 z4 = {0, 0, 0, 0};
      const bf16x8 tfrag = cat44(*(const bf16x4*)(TinvI + c16 * 40 + 4 * q4), z4);
      f32x4v Cc = {0.f, 0.f, 0.f, 0.f};
      Cc = __builtin_amdgcn_mfma_f32_16x16x32_bf16(tfrag, pk4z(rhs), Cc, 0, 0, 0);
      const bf16x8 mfrag = cat44(*(const bf16x4*)(MrbI + c16 * 40 + 4 * q4), z4);
      y = __builtin_amdgcn_mfma_f32_16x16x32_bf16(mfrag, pk4z(Cc), y, 0, 0, 0);
      bf16_t* obase = (seg ? (bf16_t*)((char*)p.out + (size_t)(2 + dir) * 64 * MiB) + (size_t)b * 2048 * 512
                           : (bf16_t*)(p.ws + OFF_CTXOUT + (size_t)(2 + dir) * 8 * MiB) + (size_t)b * 256 * 512) + h * 64 + 16 * w;
#pragma unroll
      for (int r = 0; r < 4; ++r) {
        const int li = 4 * q4 + r;
        const int tok = tlo + (dir ? 15 - li : li);
        const float val = y[r] + COEF[li] * Vf[li * 64 + 16 * w + c16];
        obase[(unsigned)(tok * 512 + c16)] = f2bf(val);
      }
      bf16x8 cuB = pk4z(Cc);
#pragma unroll
      for (int i = 0; i < 4; ++i) cuB[4 + i] = (short)f2bf(Vf[(4 * q4 + i) * 64 + 16 * w + c16]);
#pragma unroll
      for (int kt = 0; kt < 4; ++kt) {
#pragma unroll
        for (int r = 0; r < 4; ++r) STt[kt][r] *= WTs[16 * kt + 4 * q4 + r];
        const bf16x8 af = cat44(*(const bf16x4*)(BKh + (16 * kt + c16) * 40 + 4 * q4), *(const bf16x4*)(BKh + (16 * kt + c16) * 40 + 16 + 4 * q4));
        STt[kt] = __builtin_amdgcn_mfma_f32_16x16x32_bf16(af, cuB, STt[kt], 0, 0, 0);
      }
    }
    RW_LBAR()
  }
  __syncthreads();
}

__device__ __forceinline__ void fast_grid_barrier(unsigned* base, unsigned k) {
  __syncthreads();
  if (threadIdx.x == 0) {
    __builtin_amdgcn_fence(__ATOMIC_RELEASE, "agent");
    const unsigned g = blockIdx.x & 7u;
    const unsigned ng = (gridDim.x - g + 7u) >> 3;
    const unsigned old = __hip_atomic_fetch_add(base + g * 32, 1u, __ATOMIC_RELAXED, __HIP_MEMORY_SCOPE_AGENT);
    if (old == k * ng - 1u) {
      __threadfence();
      const unsigned t = __hip_atomic_fetch_add(base + 8 * 32, 1u, __ATOMIC_RELAXED, __HIP_MEMORY_SCOPE_AGENT);
      if (t == k * 8u - 1u) {
        __threadfence();
#pragma unroll
        for (int i = 0; i < 8; ++i) __hip_atomic_store(base + (9 + i) * 32, k, __ATOMIC_RELAXED, __HIP_MEMORY_SCOPE_AGENT);
      }
    }
    while (__hip_atomic_load(base + (9 + g) * 32, __ATOMIC_RELAXED, __HIP_MEMORY_SCOPE_AGENT) < k) __builtin_amdgcn_s_sleep(2);
    __builtin_amdgcn_fence(__ATOMIC_ACQUIRE, "agent");
  }
  __syncthreads();
}

__device__ __forceinline__ int next_item(int* counter, int* s_item) {
  __syncthreads();
  if (threadIdx.x == 0) *s_item = atomicAdd(counter, 1);
  __syncthreads();
  return *s_item;
}

__device__ __forceinline__ void phase_scan0(const Params& p, char* smem, int* s_item, int rep) {
  int* ctr = (int*)(p.ws + OFF_MISC + 4096) + 2 * rep;
  bool run_m = true, run_r = true;
#if PROBE_PHASE == 3
  if (rep == 0 && p.ph_hi == 13) { if (PROBE_SUB == 1) run_r = false; else run_m = false; }
#endif
  int item = next_item(ctr, s_item);
  while (item < 256) { if (run_m) mlstm_chain(p, item, smem); item = next_item(ctr, s_item); }
  while (item < 768) { if (run_r) rwkv_chain(p, item - 256, smem); item = next_item(ctr, s_item); }
}

__device__ __forceinline__ void ld8(const bf16_t* ptr, float* o) {
  const uint4 r = *(const uint4*)ptr;
  o[0] = __uint_as_float(r.x << 16); o[1] = __uint_as_float(r.x & 0xffff0000u);
  o[2] = __uint_as_float(r.y << 16); o[3] = __uint_as_float(r.y & 0xffff0000u);
  o[4] = __uint_as_float(r.z << 16); o[5] = __uint_as_float(r.z & 0xffff0000u);
  o[6] = __uint_as_float(r.w << 16); o[7] = __uint_as_float(r.w & 0xffff0000u);
}
__device__ __forceinline__ void st8(bf16_t* ptr, const float* v) {
  uint4 r;
  r.x = (unsigned)f2bf(v[0]) | ((unsigned)f2bf(v[1]) << 16);
  r.y = (unsigned)f2bf(v[2]) | ((unsigned)f2bf(v[3]) << 16);
  r.z = (unsigned)f2bf(v[4]) | ((unsigned)f2bf(v[5]) << 16);
  r.w = (unsigned)f2bf(v[6]) | ((unsigned)f2bf(v[7]) << 16);
  *(uint4*)ptr = r;
}

__device__ __forceinline__ void phase_finish0(const Params& p) {
  const int lane = threadIdx.x & 63, wave = threadIdx.x >> 6;
  const bf16_t* U = (const bf16_t*)(p.ws + OFF_RU);
  bf16_t* mix = (bf16_t*)(p.ws + OFF_RH);
  const float* mng = p.in[11];
  const float* lnw = p.in[20];
  const float* lnb = p.in[21];
  const int c0 = lane * 8;
  for (int row = blockIdx.x * 4 + wave; row < NTOK; row += gridDim.x * 4) {
    const bf16_t* urow = U + (size_t)row * LDU0;
    float a[8], bb[8], o[8], z[8], y[8];
    ld8(out0_ptr(p, 0, 0, row) + c0, a);
    ld8(out0_ptr(p, 0, 1, row) + c0, bb);
    ld8(urow + C_MO + c0, o);
    ld8(urow + C_MZ + c0, z);
    float ss = 0.f;
#pragma unroll
    for (int i = 0; i < 8; ++i) { a[i] += bb[i]; ss += a[i] * a[i]; }
#pragma unroll
    for (int of = 1; of < 16; of <<= 1) ss += __shfl_xor(ss, of, 64);
    const float rstd = rsqrtf(ss * (1.0f / 128.0f) + 1e-6f);
#pragma unroll
    for (int i = 0; i < 8; ++i) y[i] = a[i] * rstd * mng[c0 + i] * sigmoidf_(o[i]) * siluf_(z[i]);
    st8(mix + (size_t)row * 1024 + kswz(row, c0), y);
    ld8(out0_ptr(p, 1, 0, row) + c0, a);
    ld8(out0_ptr(p, 1, 1, row) + c0, bb);
    ld8(urow + C_RZ + c0, z);
    float sm = 0.f;
#pragma unroll
    for (int i = 0; i < 8; ++i) { a[i] += bb[i]; sm += a[i]; }
#pragma unroll
    for (int of = 1; of < 8; of <<= 1) sm += __shfl_xor(sm, of, 64);
    const float mu = sm * (1.0f / 64.0f);
    float sv = 0.f;
#pragma unroll
    for (int i = 0; i < 8; ++i) { a[i] -= mu; sv += a[i] * a[i]; }
#pragma unroll
    for (int of = 1; of < 8; of <<= 1) sv += __shfl_xor(sv, of, 64);
    const float rs = rsqrtf(sv * (1.0f / 64.0f) + 64e-5f);
#pragma unroll
    for (int i = 0; i < 8; ++i) y[i] = (a[i] * rs * lnw[c0 + i] + lnb[c0 + i]) * siluf_(z[i]);
    st8(mix + (size_t)row * 1024 + kswz(row, 512 + c0), y);
  }
}

__device__ __forceinline__ void phase_hyprep(const Params& p, char* smem) {
  const bf16_t* U = (const bf16_t*)(p.ws + OFF_RU);
  bf16_t* UT = (bf16_t*)(p.ws + OFF_UHY);
  bf16_t* GT = (bf16_t*)(p.ws + OFF_GHY);
  const float* sw = p.in[29];
  const float* sb = p.in[30];
  bf16_t* Tu = (bf16_t*)smem;
  bf16_t* Tg = Tu + 64 * 72;
  const int tid = opaque_tid(), cg = tid & 7, tkb = tid >> 3;
  for (int item = blockIdx.x; item < 8192; item += gridDim.x) {
    const int ct = item & 7, tt = (item >> 3) & 31, b = item >> 8;
    const int t0 = tt * 64, c0 = ct * 64 + cg * 8;
    __syncthreads();
#pragma unroll 1
    for (int ps = 0; ps < 2; ++ps) {
      const int tk = tkb + ps * 32;
      const int tp = t0 + tk;
      const bf16_t* uc = U + (size_t)(b * 2048 + tp) * LDU1;
      float sv[3][8];
#pragma unroll
      for (int part = 0; part < 3; ++part) {
        const int col = C_YV + part * 512 + c0;
        float xm[8], x0[8], xp[8];
        ld8(uc + col, x0);
        ld8(uc + (tp > 0 ? -LDU1 : 0) + col, xm);
        ld8(uc + (tp < 2047 ? LDU1 : 0) + col, xp);
#pragma unroll
        for (int i = 0; i < 8; ++i) {
          const int cc = part * 512 + c0 + i;
          const float a = (tp > 0) ? xm[i] : 0.f;
          const float c = (tp < 2047) ? xp[i] : 0.f;
          sv[part][i] = a * sw[cc] + x0[i] * sw[1536 + cc] + c * sw[3072 + cc] + sb[cc];
        }
      }
      float z[8];
      ld8(uc + C_YZ + c0, z);
#pragma unroll
      for (int i = 0; i < 8; ++i) {
        Tu[(cg * 8 + i) * 72 + tk] = f2bf(sv[2][i] * sv[0][i]);
        Tg[(cg * 8 + i) * 72 + tk] = f2bf(sv[1][i] * siluf_(z[i]));
      }
    }
    __syncthreads();
    {
      const int cl = tid >> 2, part = tid & 3;
      const size_t dst = ((size_t)(ct * 64 + cl) * 32 + b) * 2048 + t0 + part * 16;
      const uint4 u0 = *(const uint4*)(Tu + cl * 72 + part * 16), u1 = *(const uint4*)(Tu + cl * 72 + part * 16 + 8);
      const uint4 g0 = *(const uint4*)(Tg + cl * 72 + part * 16), g1 = *(const uint4*)(Tg + cl * 72 + part * 16 + 8);
      *(uint4*)(UT + dst) = u0; *(uint4*)(UT + dst + 8) = u1;
      *(uint4*)(GT + dst) = g0; *(uint4*)(GT + dst + 8) = g1;
    }
  }
  __syncthreads();
}

__device__ __forceinline__ void hgrn_chain(const Params& p, int chain, char* smem) {
  const int dir = chain & 1, h = (chain >> 1) & 3, b = chain >> 3;
  const bf16_t* U = (const bf16_t*)(p.ws + OFF_RU);
  bf16_t* Qs = (bf16_t*)smem;
  bf16_t* Ks = Qs + 64 * ML_QS;
  bf16_t* Ps = Ks;
  bf16_t* KgT = Ks + 64 * ML_QS;
  bf16_t* VT = KgT + 128 * ML_TS;
  float* sm = (float*)(VT + 128 * ML_TS);
  float* ebT = sm;
  const int tid = opaque_tid(), lane = tid & 63, w = tid >> 6;
  const int fr = lane & 31, fh = lane >> 5;
  const int si = w >> 1, ti = w & 1;
  const int cc = tid & 127, which = tid >> 7;
  const int ch = h * 128 + cc;
  const float lb = sigmoidf_(p.in[22][512 + ch] - p.in[22][ch]);
  f32x16 Ct[4];
#pragma unroll
  for (int i = 0; i < 4; ++i)
#pragma unroll
    for (int r = 0; r < 16; ++r) Ct[i][r] = 0.f;
  __syncthreads();
  for (int seg = 0; seg < 2; ++seg) {
    const int L = seg ? 2048 : 256;
    const int rowbase = seg ? b * 2048 : NLAT + b * 256;
    for (int s0 = 0; s0 < L; s0 += 64) {
      const int tlo = dir ? (L - 64 - s0) : s0;
      if (which == 0) {
        float P = 1.0f;
#pragma unroll 1
        for (int l0 = 0; l0 < 64; l0 += 16) {
          bf16_t qr[16], fr_[16];
#pragma unroll
          for (int r = 0; r < 16; ++r) {
            const int li = l0 + r;
            const int t = dir ? tlo + 63 - li : tlo + li;
            const bf16_t* up = U + (size_t)(rowbase + t) * LDU1 + ch;
            qr[r] = up[C_GQ];
            fr_[r] = up[C_GF + dir * 512];
          }
#pragma unroll
          for (int r = 0; r < 16; ++r) {
            const int li = l0 + r;
            const float q = bf2f(qr[r]);
            const float ff = bf2f(fr_[r]);
            const float f = lb + (1.0f - lb) * sigmoidf_(ff);
            const float kk = (1.0f - lb) * sigmoidf_(-ff);
            P *= f;
            Qs[li * ML_QS + cc] = f2bf(q * P);
            Ks[li * ML_QS + cc] = f2bf(kk * frcp_(P));
          }
        }
        ebT[cc] = P;
#pragma unroll 4
        for (int li = 0; li < 64; ++li) KgT[cc * ML_TS + li] = f2bf(bf2f(Ks[li * ML_QS + cc]) * P);
      } else {
#pragma unroll 1
        for (int l0 = 0; l0 < 64; l0 += 16) {
          bf16_t vr[16];
#pragma unroll
          for (int r = 0; r < 16; ++r) {
            const int li = l0 + r;
            const int t = dir ? tlo + 63 - li : tlo + li;
            vr[r] = U[(size_t)(rowbase + t) * LDU1 + C_GI + ch];
          }
#pragma unroll
          for (int r = 0; r < 16; ++r) VT[cc * ML_TS + l0 + r] = vr[r];
        }
      }
      __syncthreads();
      f32x16 sacc;
#pragma unroll
      for (int r = 0; r < 16; ++r) sacc[r] = 0.f;
      if (si <= ti) {
#pragma unroll
        for (int ks = 0; ks < 8; ++ks) {
          const bf16x8 a = *(const bf16x8*)(Ks + (si * 32 + fr) * ML_QS + ks * 16 + fh * 8);
          const bf16x8 bq = *(const bf16x8*)(Qs + (ti * 32 + fr) * ML_QS + ks * 16 + fh * 8);
          sacc = __builtin_amdgcn_mfma_f32_32x32x16_bf16(a, bq, sacc, 0, 0, 0);
        }
      }
      __syncthreads();
      if (si <= ti) {
        const int t = ti * 32 + fr;
#pragma unroll
        for (int g4 = 0; g4 < 4; ++g4) {
          float pv[4];
#pragma unroll
          for (int i = 0; i < 4; ++i) {
            const int s_ = si * 32 + 8 * g4 + 4 * fh + i;
            pv[i] = (s_ <= t) ? sacc[4 * g4 + i] : 0.f;
          }
          uint2 pk;
          pk.x = (unsigned)f2bf(pv[0]) | ((unsigned)f2bf(pv[1]) << 16);
          pk.y = (unsigned)f2bf(pv[2]) | ((unsigned)f2bf(pv[3]) << 16);
          *(uint2*)(Ps + t * ML_TS + si * 32 + 8 * g4 + 4 * fh) = pk;
        }
      }
      __syncthreads();
      bf16_t* obase = (bf16_t*)(p.ws + OFF_RH) + (size_t)dir * NLAT * 512 + (size_t)b * 2048 * 512 + h * 128 + w * 32;
#pragma unroll 1
      for (int t2 = 0; t2 < 2; ++t2) {
        f32x16 num;
#pragma unroll
        for (int r = 0; r < 16; ++r) num[r] = 0.f;
#pragma unroll
        for (int di = 0; di < 4; ++di)
#pragma unroll
          for (int s2 = 0; s2 < 2; ++s2) {
            const int d0 = di * 32 + 16 * s2;
            const bf16x4 qa = *(const bf16x4*)(Qs + (t2 * 32 + fr) * ML_QS + d0 + 4 * fh);
            const bf16x4 qb = *(const bf16x4*)(Qs + (t2 * 32 + fr) * ML_QS + d0 + 8 + 4 * fh);
            bf16x8 a;
            a[0] = qa[0]; a[1] = qa[1]; a[2] = qa[2]; a[3] = qa[3];
            a[4] = qb[0]; a[5] = qb[1]; a[6] = qb[2]; a[7] = qb[3];
            num = __builtin_amdgcn_mfma_f32_32x32x16_bf16(a, pack8(Ct[di], s2), num, 0, 0, 0);
            __builtin_amdgcn_sched_barrier(0);
          }
        const int nks = 2 * (t2 + 1);
        for (int ks = 0; ks < nks; ++ks) {
          const bf16x8 a = *(const bf16x8*)(Ps + (t2 * 32 + fr) * ML_TS + ks * 16 + fh * 8);
          const bf16x8 bv = *(const bf16x8*)(VT + (w * 32 + fr) * ML_TS + ks * 16 + fh * 8);
          num = __builtin_amdgcn_mfma_f32_32x32x16_bf16(a, bv, num, 0, 0, 0);
        }
        if (seg) {
#pragma unroll
          for (int r = 0; r < 16; ++r) {
            const int t = t2 * 32 + (r & 3) + 8 * (r >> 2) + 4 * fh;
            const int tok = tlo + (dir ? 63 - t : t);
            obase[(unsigned)(tok * 512 + fr)] = f2bf(num[r]);
          }
        }
      }
#pragma unroll
      for (int di = 0; di < 4; ++di) {
#pragma unroll
        for (int r = 0; r < 16; ++r) Ct[di][r] *= ebT[di * 32 + (r & 3) + 8 * (r >> 2) + 4 * fh];
#pragma unroll
        for (int ks = 0; ks < 4; ++ks) {
          const bf16x8 a = *(const bf16x8*)(KgT + (di * 32 + fr) * ML_TS + ks * 16 + fh * 8);
          const bf16x8 bv = *(const bf16x8*)(VT + (w * 32 + fr) * ML_TS + ks * 16 + fh * 8);
          Ct[di] = __builtin_amdgcn_mfma_f32_32x32x16_bf16(a, bv, Ct[di], 0, 0, 0);
        }
        __builtin_amdgcn_sched_barrier(0);
      }
      __syncthreads();
    }
  }
}

__device__ __forceinline__ void hyconv_item(const Params& p, int c, char* smem, bool dry) {
  const bf16_t* UT = (const bf16_t*)(p.ws + OFF_UHY);
  bf16_t* GT = (bf16_t*)(p.ws + OFF_GHY);
  const float* KERNT = (const float*)(p.ws + OFF_KERN) + (size_t)c * 4096;
  uint4* Vt = (uint4*)smem;
  bf16_t* KTs = (bf16_t*)(smem + 65536);
  const int tid = opaque_tid(), lane = tid & 63, w = tid >> 6;
  const int fr = lane & 31, fh = lane >> 5;
  __syncthreads();
  if (tid < 8) KTs[tid] = 0;
#pragma unroll 4
  for (int m = tid; m < 4096; m += NTHREADS) KTs[8 + m] = f2bf(KERNT[m]);
  __syncthreads();
#pragma unroll 2
  for (int m = tid; m < 4096; m += NTHREADS) {
    uint4 v;
    v.x = (unsigned)KTs[8 + m] | ((unsigned)KTs[8 + m - 1] << 16);
    v.y = (unsigned)KTs[8 + m - 2] | ((unsigned)KTs[8 + m - 3] << 16);
    v.z = (unsigned)KTs[8 + m - 4] | ((unsigned)KTs[8 + m - 5] << 16);
    v.w = (unsigned)KTs[8 + m - 6] | ((unsigned)KTs[8 + m - 7] << 16);
    Vt[m] = v;
  }
  __syncthreads();
  const float bc = p.in[36][c];
  const bf16_t* ub = UT + ((size_t)c * 32 + fr) * 2048 + 8 * fh;
#pragma unroll 1
  for (int tg = 0; tg < 4; ++tg) {
    const int t0g = w * 512 + tg * 128;
    f32x16 acc[4];
#pragma unroll
    for (int q = 0; q < 4; ++q)
#pragma unroll
      for (int r = 0; r < 16; ++r) acc[q][r] = 0.f;
    const int mbase = t0g + fr - 8 * fh + 2048;
#pragma unroll 8
    for (int s0 = 0; s0 < 2048; s0 += 16) {
      const bf16x8 bfrag = *(const bf16x8*)(ub + s0);
#pragma unroll
      for (int q = 0; q < 4; ++q) {
        const bf16x8 a = *(const bf16x8*)(Vt + (mbase + q * 32 - s0));
        acc[q] = __builtin_amdgcn_mfma_f32_32x32x16_bf16(a, bfrag, acc[q], 0, 0, 0);
      }
    }
#pragma unroll
    for (int q = 0; q < 4; ++q)
#pragma unroll
      for (int g4 = 0; g4 < 4; ++g4) {
        const int t = t0g + q * 32 + 8 * g4 + 4 * fh;
        const size_t idx = ((size_t)c * 32 + fr) * 2048 + t;
        const uint2 gu = *(const uint2*)(GT + idx);
        const uint2 uu = *(const uint2*)(UT + idx);
        float gv[4], uv[4], o[4];
        gv[0] = __uint_as_float(gu.x << 16); gv[1] = __uint_as_float(gu.x & 0xffff0000u);
        gv[2] = __uint_as_float(gu.y << 16); gv[3] = __uint_as_float(gu.y & 0xffff0000u);
        uv[0] = __uint_as_float(uu.x << 16); uv[1] = __uint_as_float(uu.x & 0xffff0000u);
        uv[2] = __uint_as_float(uu.y << 16); uv[3] = __uint_as_float(uu.y & 0xffff0000u);
#pragma unroll
        for (int i = 0; i < 4; ++i) o[i] = gv[i] * (acc[q][4 * g4 + i] + bc * uv[i]);
        uint2 pk;
        pk.x = (unsigned)f2bf(o[0]) | ((unsigned)f2bf(o[1]) << 16);
        pk.y = (unsigned)f2bf(o[2]) | ((unsigned)f2bf(o[3]) << 16);
        if (!dry) *(uint2*)(GT + idx) = pk;
      }
  }
  __syncthreads();
}

__device__ __forceinline__ void phase_scan1(const Params& p, char* smem, int* s_item, int rep) {
  int* ctr = (int*)(p.ws + OFF_MISC + 4096) + 1 + 2 * rep;
  for (;;) {
    const int item = next_item(ctr, s_item);
    if (item >= 256 + 512) break;
    if (item < 256) hgrn_chain(p, item, smem);
    else hyconv_item(p, item - 256, smem, (PROBE_PHASE == 9) && rep == 0 && p.ph_hi == 13);
  }
}

__device__ __forceinline__ void phase_finish1(const Params& p, char* smem) {
  const int lane = threadIdx.x & 63, wave = threadIdx.x >> 6;
  const bf16_t* U = (const bf16_t*)(p.ws + OFF_RU);
  bf16_t* g0 = (bf16_t*)(p.ws + OFF_RH);
  const bf16_t* g1 = g0 + (size_t)NLAT * 512;
  const float* gng = p.in[28];
  const int c0 = lane * 8;
  for (int row = blockIdx.x * 4 + wave; row < NLAT; row += gridDim.x * 4) {
    float a[8], bb[8], z[8], y[8];
    ld8(g0 + (size_t)row * 512 + c0, a);
    ld8(g1 + (size_t)row * 512 + c0, bb);
    ld8(U + (size_t)row * LDU1 + C_GZ + c0, z);
    float ss = 0.f;
#pragma unroll
    for (int i = 0; i < 8; ++i) { a[i] += bb[i]; ss += a[i] * a[i]; }
#pragma unroll
    for (int of = 1; of < 16; of <<= 1) ss += __shfl_xor(ss, of, 64);
    const float rstd = rsqrtf(ss * (1.0f / 128.0f) + 1e-6f);
#pragma unroll
    for (int i = 0; i < 8; ++i) y[i] = a[i] * rstd * gng[c0 + i] * siluf_(z[i]);
    st8(g0 + (size_t)row * 512 + kswz(row, c0), y);
  }
  {
    const bf16_t* YT = (const bf16_t*)(p.ws + OFF_GHY);
    bf16_t* Yo = (bf16_t*)(p.ws + OFF_UHY);
    bf16_t* Tt = (bf16_t*)smem;
    const int tid = opaque_tid();
    for (int item = blockIdx.x; item < 8192; item += gridDim.x) {
      const int ct = item & 7, tt = (item >> 3) & 31, b = item >> 8;
      const int t0 = tt * 64;
      __syncthreads();
      {
        const int cl = tid >> 2, part = tid & 3;
        const size_t src = ((size_t)(ct * 64 + cl) * 32 + b) * 2048 + t0 + part * 16;
        *(uint4*)(Tt + cl * 72 + part * 16) = *(const uint4*)(YT + src);
        *(uint4*)(Tt + cl * 72 + part * 16 + 8) = *(const uint4*)(YT + src + 8);
      }
      __syncthreads();
      {
        const int tk = tid >> 2, cq = tid & 3;
        unsigned pk[8];
#pragma unroll
        for (int i = 0; i < 8; ++i)
          pk[i] = (unsigned)Tt[(cq * 16 + 2 * i) * 72 + tk] | ((unsigned)Tt[(cq * 16 + 2 * i + 1) * 72 + tk] << 16);
        bf16_t* dst = Yo + (size_t)(b * 2048 + t0 + tk) * 512 + kswz(b * 2048 + t0 + tk, ct * 64) + cq * 16;
        *(uint4*)dst = make_uint4(pk[0], pk[1], pk[2], pk[3]);
        *(uint4*)(dst + 8) = make_uint4(pk[4], pk[5], pk[6], pk[7]);
      }
    }
    __syncthreads();
  }
}

__device__ __forceinline__ void phase_final(const Params& p) {
  const int lane = threadIdx.x & 63, wave = threadIdx.x >> 6;
  const float* g = p.in[37];
  for (int row = blockIdx.x * 4 + wave; row < NLAT; row += gridDim.x * 4) {
    float* src = p.out + (size_t)row * 1024;
    float4 v[4];
    float ss = 0.f;
#pragma unroll
    for (int i = 0; i < 4; ++i) {
      v[i] = *(const float4*)(src + i * 256 + lane * 4);
      ss += v[i].x * v[i].x + v[i].y * v[i].y + v[i].z * v[i].z + v[i].w * v[i].w;
    }
    ss = wave_sum(ss);
    const float rstd = rsqrtf(ss * (1.0f / 1024.0f) + 1e-6f);
#pragma unroll
    for (int i = 0; i < 4; ++i) {
      const int c = i * 256 + lane * 4;
      const float4 gg = *(const float4*)(g + c);
      float4 o;
      o.x = v[i].x * rstd * gg.x; o.y = v[i].y * rstd * gg.y; o.z = v[i].z * rstd * gg.z; o.w = v[i].w * rstd * gg.w;
      *(float4*)(src + c) = o;
    }
  }
}

#define NPHASES 13
__global__ void __launch_bounds__(NTHREADS, 2) mega_kernel(Params p) {
  __shared__ __attribute__((aligned(16))) char smem[SMEM_BYTES];
  __shared__ int s_item;
  cg::grid_group grid = cg::this_grid();
  unsigned* bar_ctr = (unsigned*)(p.ws + OFF_MISC + 12288);
  unsigned bar_idx = 0;
  bool first_bar = true;
#define GRID_BAR() { if (first_bar) { grid.sync(); first_bar = false; } else { ++bar_idx; fast_grid_barrier(bar_ctr, bar_idx); } }
#define PH_BEGIN(n) if (p.ph_lo <= (n) && (n) < p.ph_hi) { if ((n) > p.ph_lo) GRID_BAR() for (int rep = 0; rep < ((n) == PROBE_PHASE ? 2 : 1); ++rep) { if (rep) GRID_BAR()
#define PH_END }}
  PH_BEGIN(0) phase_setup(p, smem); PH_END
  PH_BEGIN(1) phase_h(p, 0); phase_fnorm(p, smem); PH_END
  PH_BEGIN(2)
    phase_kern(p);
    EpiStoreBf16 epi{(bf16_t*)(p.ws + OFF_RU), LDU0, LDU0};
    const bf16_t* A = (const bf16_t*)(p.ws + OFF_RH);
    gemm_tiles(A, 1024, A + 512, 1024, (const bf16_t*)(p.ws + OFF_WIN0T), NTOK / 256, 39, epi, smem);
  PH_END
  PH_BEGIN(3) phase_scan0(p, smem, &s_item, rep); PH_END
  PH_BEGIN(4) phase_finish0(p); PH_END
  PH_BEGIN(5)
    EpiOut0 epi{p.in[0], p.in[2], (const float*)(p.ws + OFF_MOD), p.out, (float*)(p.ws + OFF_XC1)};
    const bf16_t* A = (const bf16_t*)(p.ws + OFF_RH);
    gemm_tiles(A, 1024, A + 512, 1024, (const bf16_t*)(p.ws + OFF_WOUT0T), NTOK / 256, 8, epi, smem);
  PH_END
  PH_BEGIN(6) phase_h(p, 1); PH_END
  PH_BEGIN(7)
    EpiStoreBf16 epi{(bf16_t*)(p.ws + OFF_RU), LDU1, LDU1};
    const bf16_t* A = (const bf16_t*)(p.ws + OFF_RH);
    gemm_tiles(A, 1024, A + 512, 1024, (const bf16_t*)(p.ws + OFF_WIN1T), NTOK / 256, 36, epi, smem, NLAT / 256, 20);
  PH_END
  PH_BEGIN(8) phase_hyprep(p, smem); PH_END
  PH_BEGIN(9) phase_scan1(p, smem, &s_item, rep); PH_END
  PH_BEGIN(10) phase_finish1(p, smem); PH_END
  PH_BEGIN(11)
    EpiOut1 epi{(const float*)(p.ws + OFF_MOD) + 33 * 3072, p.out};
    gemm_tiles((const bf16_t*)(p.ws + OFF_RH), 512, (const bf16_t*)(p.ws + OFF_UHY), 512,
               (const bf16_t*)(p.ws + OFF_WOUT1T), NLAT / 256, 8, epi, smem);
  PH_END
  PH_BEGIN(12) phase_final(p); PH_END
}

#ifndef MULTI_LAUNCH
#define MULTI_LAUNCH 0
#endif

extern "C" void kernel_launch(void* const* d_in, const int* in_sizes, int n_in, void* d_out, int out_size, void* d_ws, size_t ws_size,
                              hipStream_t stream) {
  static int grid_blocks = 0;
  if (!grid_blocks) {
    int dev = 0, cus = 0, per_cu = 0;
    hipGetDevice(&dev);
    hipDeviceGetAttribute(&cus, hipDeviceAttributeMultiprocessorCount, dev);
    hipOccupancyMaxActiveBlocksPerMultiprocessor(&per_cu, (const void*)mega_kernel, NTHREADS, 0);
    if (per_cu > 2) per_cu = 2;
    if (per_cu < 1) per_cu = 1;
    grid_blocks = cus * per_cu;
    if (ws_size < WS_NEED) fprintf(stderr, "kernel_launch: workspace too small: %zu < %zu\n", ws_size, (size_t)WS_NEED);
    if (n_in != 38) fprintf(stderr, "kernel_launch: expected 38 inputs, got %d\n", n_in);
  }
  Params p{};
  for (int i = 0; i < 38; ++i) p.in[i] = (const float*)d_in[i];
  p.out = (float*)d_out;
  p.ws = (char*)d_ws;
#if MULTI_LAUNCH
  for (int ph = 0; ph < NPHASES; ++ph) {
    p.ph_lo = ph; p.ph_hi = ph + 1;
    hipLaunchKernelGGL(mega_kernel, dim3(grid_blocks), dim3(NTHREADS), 0, stream, p);
  }
#else
  p.ph_lo = 0; p.ph_hi = NPHASES;
  void* args[] = {&p};
  hipError_t e = hipLaunchCooperativeKernel((const void*)mega_kernel, dim3(grid_blocks), dim3(NTHREADS), args, 0, stream);
  if (e != hipSuccess) fprintf(stderr, "cooperative launch failed: %s (grid %d)\n", hipGetErrorString(e), grid_blocks);
#endif
}
```

```cpp
#include <hip/hip_runtime.h>
#include <hip/hip_bf16.h>
#include <hip/hip_cooperative_groups.h>
#include <cstdio>
namespace cg = cooperative_groups;

typedef unsigned short bf16_t;
using bf16x8 = __attribute__((ext_vector_type(8))) short;
using f32x16 = __attribute__((ext_vector_type(16))) float;

#define NLAT 65536
#define NCTX 8192
#define NTOK 73728
#define LDU0 4880
#define LDU1 4608
#define NTHREADS 256
#ifndef PROBE_PHASE
#define PROBE_PHASE -1
#endif
#define PROBE_SUB 1
#define SMEM_BYTES 75776

constexpr size_t MiB = 1ull << 20;
constexpr size_t OFF_WIN0T = 0;
constexpr size_t OFF_WOUT0T = 10 * MiB;
constexpr size_t OFF_WIN1T = 12 * MiB;
constexpr size_t OFF_WOUT1T = 21 * MiB;
constexpr size_t OFF_MOD = 23 * MiB;
constexpr size_t OFF_FILT = 24 * MiB;
constexpr size_t OFF_KERN = 32 * MiB;
constexpr size_t OFF_MISC = 40 * MiB;
constexpr size_t OFF_RH = 41 * MiB;
constexpr size_t OFF_RU = 185 * MiB;
constexpr size_t OFF_CTXOUT = 872 * MiB;
constexpr size_t OFF_XC1 = 904 * MiB;
constexpr size_t OFF_UHY = 833 * MiB;
constexpr size_t OFF_GHY = 897 * MiB;
constexpr size_t WS_NEED = 961 * MiB;

#define C_MQ 0
#define C_MK 512
#define C_MV 1024
#define C_MO 1536
#define C_MZ 2048
#define C_MG 2560
#define C_RR 2576
#define C_RK 3088
#define C_RV 3600
#define C_RZ 4112
#define C_WD 4624
#define C_AD 4752
#define C_GQ 0
#define C_GI 512
#define C_GF 1024
#define C_GZ 2048
#define C_YV 2560
#define C_Y0 3072
#define C_Y1 3584
#define C_YZ 4096

struct Params {
  const float* in[38];
  float* out;
  char* ws;
  int ph_lo, ph_hi;
};

__device__ __forceinline__ bf16_t f2bf(float f) {
  const __bf16 b = (__bf16)f;
  return __builtin_bit_cast(unsigned short, b);
}
__device__ __forceinline__ float bf2f(bf16_t h) { return __uint_as_float(((unsigned)h) << 16); }
__device__ __forceinline__ float frcp_(float x) { return __builtin_amdgcn_rcpf(x); }
__device__ __forceinline__ float sigmoidf_(float x) { return frcp_(1.0f + __expf(-x)); }
__device__ __forceinline__ float siluf_(float x) { return x * frcp_(1.0f + __expf(-x)); }
__device__ __forceinline__ float tanh_fast(float x) { return 1.0f - 2.0f * frcp_(1.0f + __expf(2.0f * x)); }
__device__ __forceinline__ int kswz(int row, int k) { return ((((k >> 6) ^ (row & 7)) << 6) | (k & 63)); }
__device__ __forceinline__ int opaque_tid() { int t = threadIdx.x; asm volatile("" : "+v"(t)); return t; }
template <int CTRL> __device__ __forceinline__ float dpp_mov(float v) {
  return __int_as_float(__builtin_amdgcn_mov_dpp(__float_as_int(v), CTRL, 0xF, 0xF, true));
}
__device__ __forceinline__ float wave_sum(float v) {
  v += dpp_mov<0xB1>(v);
  v += dpp_mov<0x4E>(v);
  v += dpp_mov<0x141>(v);
  v += dpp_mov<0x140>(v);
  const int vi = __float_as_int(v);
  return __int_as_float(__builtin_amdgcn_readlane(vi, 0)) + __int_as_float(__builtin_amdgcn_readlane(vi, 16)) +
         __int_as_float(__builtin_amdgcn_readlane(vi, 32)) + __int_as_float(__builtin_amdgcn_readlane(vi, 48));
}

#define G_LDS 40
template <class Epi>
__device__ __forceinline__ void gemm_tiles(const bf16_t* __restrict__ A1, int lda1, const bf16_t* __restrict__ A2, int lda2,
                           const bf16_t* __restrict__ Bt, int Mtiles, int Ntiles, Epi epi, char* smem, int skip_mt = 1 << 30, int skip_nt = 1 << 30) {
  const int tid = opaque_tid(), lane = tid & 63, wave = tid >> 6, wm = wave >> 1, wn = wave & 1;
  const int lr = tid >> 2, lc = tid & 3;
  const int fr = lane & 31, fh = lane >> 5;
  const int ntiles = Mtiles * Ntiles;
  const bool swz = ((gridDim.x & 7) == 0) && ((Mtiles & 31) == 0);
  const int xcd = blockIdx.x & 7;
  const int nper = swz ? ntiles / 8 : ntiles;
  const int start = swz ? (blockIdx.x >> 3) : blockIdx.x;
  const int step = swz ? (gridDim.x >> 3) : gridDim.x;
  for (int lt = start; lt < nper; lt += step) {
    int mt, nt;
    if (swz) {
      const int g = lt / (4 * Ntiles), within = lt % (4 * Ntiles);
      nt = within >> 2;
      mt = xcd * (Mtiles >> 3) + g * 4 + (within & 3);
    } else { mt = lt / Ntiles; nt = lt % Ntiles; }
    if (mt >= skip_mt && nt >= skip_nt) continue;
    const int row0 = mt * 256, col0 = nt * 128;
    f32x16 acc[4][2];
#pragma unroll
    for (int i = 0; i < 4; ++i)
#pragma unroll
      for (int j = 0; j < 2; ++j)
#pragma unroll
        for (int r = 0; r < 16; ++r) acc[i][j][r] = 0.f;
    const unsigned aoff = (unsigned)(((row0 + lr) * lda1 + lc * 8) * 2);
    const unsigned boff = (unsigned)(((col0 + lr) * 1024 + lc * 8) * 2);
    const unsigned astrb = (unsigned)(64 * lda1 * 2);
    uint4 Pa0, Pa1, Pa2, Pa3, Pb0, Pb1;
#define LD16(base_, off_) (*(const uint4*)((const char*)(base_) + (off_)))
#define G_KOFF(k_) ((unsigned)((((((k_) >> 1) & 7) ^ (lr & 7)) * 128) + ((k_) & 1) * 64))
#define G_LOADX(k_) { const char* ab_ = ((k_) < 16) ? (const char*)A1 : (const char*)A2; const unsigned ko_ = G_KOFF(k_); \
                      const unsigned ao_ = aoff + ko_; const unsigned bo_ = boff + ko_ + (((k_) >= 16) ? 1024u : 0u); \
                      Pa0 = LD16(ab_, ao_); Pa1 = LD16(ab_, ao_ + astrb); Pa2 = LD16(ab_, ao_ + 2 * astrb); Pa3 = LD16(ab_, ao_ + 3 * astrb); \
                      Pb0 = LD16(Bt, bo_); Pb1 = LD16(Bt, bo_ + 131072u); }
#define G_STOREX(stage_) { bf16_t* pa_ = (bf16_t*)smem + (stage_) * (384 * G_LDS) + lr * G_LDS + lc * 8; bf16_t* pb_ = pa_ + 256 * G_LDS; \
                           *(uint4*)(pa_) = Pa0; *(uint4*)(pa_ + 64 * G_LDS) = Pa1; *(uint4*)(pa_ + 128 * G_LDS) = Pa2; *(uint4*)(pa_ + 192 * G_LDS) = Pa3; \
                           *(uint4*)(pb_) = Pb0; *(uint4*)(pb_ + 64 * G_LDS) = Pb1; }
#define G_COMPUTE(stage_) { \
      const bf16_t* As = (const bf16_t*)smem + (stage_) * (384 * G_LDS); \
      const bf16_t* Bs = As + 256 * G_LDS; \
      _Pragma("unroll") for (int s = 0; s < 2; ++s) { \
        bf16x8 a[4], b[2]; \
        _Pragma("unroll") for (int i = 0; i < 4; ++i) a[i] = *(const bf16x8*)(As + (wm * 128 + i * 32 + fr) * G_LDS + s * 16 + fh * 8); \
        _Pragma("unroll") for (int j = 0; j < 2; ++j) b[j] = *(const bf16x8*)(Bs + (wn * 64 + j * 32 + fr) * G_LDS + s * 16 + fh * 8); \
        _Pragma("unroll") for (int i = 0; i < 4; ++i) \
          _Pragma("unroll") for (int j = 0; j < 2; ++j) acc[i][j] = __builtin_amdgcn_mfma_f32_32x32x16_bf16(a[i], b[j], acc[i][j], 0, 0, 0); \
      } \
      asm volatile("s_waitcnt lgkmcnt(0)" ::: "memory"); \
      __builtin_amdgcn_s_barrier(); \
      asm volatile("" ::: "memory"); }
    G_LOADX(0)
    { asm volatile("s_waitcnt lgkmcnt(0)" ::: "memory"); __builtin_amdgcn_s_barrier(); asm volatile("" ::: "memory"); }
    G_STOREX(0)
    G_LOADX(1)
    { asm volatile("s_waitcnt lgkmcnt(0)" ::: "memory"); __builtin_amdgcn_s_barrier(); asm volatile("" ::: "memory"); }
#pragma unroll 2
    for (int kt = 0; kt < 32; ++kt) {
      const int cur = kt & 1;
      if (kt + 1 < 32) G_STOREX(cur ^ 1)
      if (kt + 2 < 32) G_LOADX(kt + 2)
      G_COMPUTE(cur)
    }
    float* Cs = (float*)smem;
#pragma unroll
    for (int hh = 0; hh < 2; ++hh) {
      if (hh) { asm volatile("s_waitcnt lgkmcnt(0)" ::: "memory"); __builtin_amdgcn_s_barrier(); asm volatile("" ::: "memory"); }
      if (wm == hh) {
#pragma unroll
        for (int i = 0; i < 4; ++i)
#pragma unroll
          for (int j = 0; j < 2; ++j)
#pragma unroll
            for (int r = 0; r < 16; ++r) {
              const int row = i * 32 + (r & 3) + 8 * (r >> 2) + 4 * fh;
              const int col = wn * 64 + j * 32 + fr;
              Cs[row * 132 + col] = acc[i][j][r];
            }
      }
      { asm volatile("s_waitcnt lgkmcnt(0)" ::: "memory"); __builtin_amdgcn_s_barrier(); asm volatile("" ::: "memory"); }
#pragma unroll
      for (int it = 0; it < 8; ++it) {
        const int idx = it * 256 + tid;
        const int row = idx >> 4, c8 = (idx & 15) * 8;
        const float4 v0 = *(const float4*)(Cs + row * 132 + c8);
        const float4 v1 = *(const float4*)(Cs + row * 132 + c8 + 4);
        float v[8] = {v0.x, v0.y, v0.z, v0.w, v1.x, v1.y, v1.z, v1.w};
        epi(row0 + hh * 128 + row, col0 + c8, v);
      }
    }
  }
  __syncthreads();
}

__device__ __forceinline__ void st8(bf16_t* ptr, const float* v);

struct EpiStoreBf16 {
  bf16_t* U; int ldu; int N;
  __device__ __forceinline__ void operator()(int row, int col, const float* v) const {
    if (col < N) st8(U + (size_t)row * ldu + col, v);
  }
};
__device__ __forceinline__ void resid8(float* dst, const float* src, const float* gate, const float* v) {
  const float4 x0 = *(const float4*)src, x1 = *(const float4*)(src + 4);
  const float4 g0 = *(const float4*)gate, g1 = *(const float4*)(gate + 4);
  float4 o0, o1;
  o0.x = x0.x + g0.x * v[0]; o0.y = x0.y + g0.y * v[1]; o0.z = x0.z + g0.z * v[2]; o0.w = x0.w + g0.w * v[3];
  o1.x = x1.x + g1.x * v[4]; o1.y = x1.y + g1.y * v[5]; o1.z = x1.z + g1.z * v[6]; o1.w = x1.w + g1.w * v[7];
  *(float4*)dst = o0; *(float4*)(dst + 4) = o1;
}
struct EpiOut0 {
  const float* x; const float* ctx; const float* mod; float* x1; float* xc1;
  __device__ __forceinline__ void operator()(int row, int col, const float* v) const {
    if (row < NLAT) {
      const int b = row >> 11;
      const size_t idx = (size_t)row * 1024 + col;
      resid8(x1 + idx, x + idx, mod + b * 3072 + 2048 + col, v);
    } else {
      const size_t idx = (size_t)(row - NLAT) * 1024 + col;
      resid8(xc1 + idx, ctx + idx, mod + 32 * 3072 + 2048 + col, v);
    }
  }
};
struct EpiOut1 {
  const float* mod; float* x1;
  __device__ __forceinline__ void operator()(int row, int col, const float* v) const {
    const int b = row >> 11, tp = row & 2047;
    const int t = (tp & 31) * 64 + (tp >> 5);
    const size_t idx = ((size_t)b * 2048 + t) * 1024 + col;
    resid8(x1 + idx, x1 + idx, mod + b * 3072 + 2048 + col, v);
  }
};

__device__ __forceinline__ void transpose_item(const float* __restrict__ W, int N, bf16_t* __restrict__ WT, int item, char* smem) {
  float* tile = (float*)smem;
  const int kt = item & 15, ntile = item >> 4;
  const int k0 = kt * 64, n0 = ntile * 64;
  const int tid = opaque_tid();
  __syncthreads();
#pragma unroll
  for (int i = 0; i < 16; ++i) {
    const int k = i * 4 + (tid >> 6), n = tid & 63;
    float v = 0.f;
    if (n0 + n < N) v = W[(size_t)(k0 + k) * N + n0 + n];
    tile[k * 65 + n] = v;
  }
  __syncthreads();
#pragma unroll
  for (int i = 0; i < 16; ++i) {
    const int n = i * 4 + (tid >> 6), k = tid & 63;
    WT[(size_t)(n0 + n) * 1024 + kswz(n0 + n, k0 + k)] = f2bf(tile[k * 65 + n]);
  }
}

__device__ __forceinline__ void adaln_item(const Params& p, int item, char* smem) {
  const int layer = item / 48, cgp = item % 48;
  const float* mod_w = p.in[layer ? 24 : 5];
  const float* mod_b = p.in[layer ? 25 : 6];
  const float* cvec = p.in[1];
  const float* cctx = p.in[3];
  float* mod = (float*)(p.ws + OFF_MOD) + layer * 33 * 3072;
  float* sc = (float*)smem;
  float* red = sc + 33 * 128;
  const int tid = opaque_tid(), kq = tid >> 6, n = tid & 63;
  const int ncol = cgp * 64 + n;
  float acc[33];
#pragma unroll
  for (int r = 0; r < 33; ++r) acc[r] = 0.f;
  for (int kc = 0; kc < 1024; kc += 128) {
    __syncthreads();
    for (int e = tid; e < 33 * 128; e += NTHREADS) {
      const int r = e >> 7, kk = e & 127;
      const float v = (r < 32) ? cvec[r * 1024 + kc + kk] : cctx[kc + kk];
      sc[e] = siluf_(v);
    }
    __syncthreads();
#pragma unroll 2
    for (int kk = kq * 32; kk < kq * 32 + 32; ++kk) {
      const float w = mod_w[(size_t)(kc + kk) * 3072 + ncol];
#pragma unroll
      for (int r = 0; r < 33; ++r) acc[r] += sc[r * 128 + kk] * w;
    }
  }
  __syncthreads();
#pragma unroll
  for (int r = 0; r < 33; ++r) red[(kq * 33 + r) * 64 + n] = acc[r];
  __syncthreads();
  for (int e = tid; e < 33 * 64; e += NTHREADS) {
    const int r = e >> 6, nn = e & 63;
    const float s = red[(0 * 33 + r) * 64 + nn] + red[(1 * 33 + r) * 64 + nn] + red[(2 * 33 + r) * 64 + nn] + red[(3 * 33 + r) * 64 + nn];
    mod[r * 3072 + cgp * 64 + nn] = s + mod_b[cgp * 64 + nn];
  }
}

__device__ __forceinline__ void hyena_filter_item(const Params& p, int item, char* smem) {
  const float* w1 = p.in[31]; const float* b1 = p.in[32];
  const float* w2 = p.in[33]; const float* b2 = p.in[34];
  const float* w3 = p.in[35];
  float* FILT = (float*)(p.ws + OFF_FILT);
  float* z = (float*)smem;
  float* h1 = z + 8 * 36;
  float* h2 = h1 + 8 * 64;
  const int tid = opaque_tid();
  const int pos0 = item * 8;
  __syncthreads();
  for (int e = tid; e < 8 * 33; e += NTHREADS) {
    const int pp = e / 33, i = e % 33;
    const float pos = (float)(pos0 + pp);
    float v;
    if (i == 0) v = pos / 2048.0f;
    else {
      const int bi = (i - 1) & 15;
      const float band = 1e-4f + (float)bi * ((15.0f - 1e-4f) / 15.0f);
      const float ang = (6.283185307179586f / 2048.0f) * pos * band;
      v = (i <= 16) ? cosf(ang) : sinf(ang);
    }
    z[pp * 36 + i] = v;
  }
  __syncthreads();
  for (int e = tid; e < 8 * 64; e += NTHREADS) {
    const int pp = e >> 6, j = e & 63;
    float s = b1[j];
#pragma unroll 1
    for (int i = 0; i < 33; ++i) s += z[pp * 36 + i] * w1[i * 64 + j];
    h1[pp * 64 + j] = sinf(s);
  }
  __syncthreads();
  for (int e = tid; e < 8 * 64; e += NTHREADS) {
    const int pp = e >> 6, j = e & 63;
    float s = b2[j];
#pragma unroll 4
    for (int i = 0; i < 64; ++i) s += h1[pp * 64 + i] * w2[i * 64 + j];
    h2[pp * 64 + j] = sinf(s);
  }
  __syncthreads();
  const float min_decay = -3.0701134573253946f, max_decay = -15.350567286626973f;
#pragma unroll 1
  for (int q = 0; q < 4; ++q) {
    const int cc = q * 256 + tid;
    const int dir = cc >> 9, c = cc & 511;
    float s[8];
#pragma unroll
    for (int pp = 0; pp < 8; ++pp) s[pp] = 0.f;
#pragma unroll 4
    for (int j = 0; j < 64; ++j) {
      const float w = w3[j * 1024 + cc];
#pragma unroll
      for (int pp = 0; pp < 8; ++pp) s[pp] += h2[pp * 64 + j] * w;
    }
    const float delta = fabsf(min_decay + (float)c * ((max_decay - min_decay) / 511.0f));
#pragma unroll
    for (int pp = 0; pp < 8; ++pp) {
      const float t = (float)(pos0 + pp) / 2048.0f;
      const float win = expf(-t * delta) + 0.05f;
      FILT[((size_t)dir * 2048 + pos0 + pp) * 512 + c] = s[pp] * win;
    }
  }
}

__device__ __forceinline__ void phase_setup(const Params& p, char* smem) {
  if (blockIdx.x == 0 && threadIdx.x < 16) ((int*)(p.ws + OFF_MISC + 4096))[threadIdx.x] = 0;
  if (blockIdx.x == 0) { unsigned* bz = (unsigned*)(p.ws + OFF_MISC + 12288); for (int i = threadIdx.x; i < 1024; i += NTHREADS) bz[i] = 0u; }
  for (int item = blockIdx.x; item < 3264; item += gridDim.x) {
    if (item < 1248) transpose_item(p.in[7], 4880, (bf16_t*)(p.ws + OFF_WIN0T), item, smem);
    else if (item < 1504) transpose_item(p.in[8], 1024, (bf16_t*)(p.ws + OFF_WOUT0T), item - 1248, smem);
    else if (item < 2656) transpose_item(p.in[26], 4608, (bf16_t*)(p.ws + OFF_WIN1T), item - 1504, smem);
    else if (item < 2912) transpose_item(p.in[27], 1024, (bf16_t*)(p.ws + OFF_WOUT1T), item - 2656, smem);
    else if (item < 3008) adaln_item(p, item - 2912, smem);
    else hyena_filter_item(p, item - 3008, smem);
  }
}

__device__ __forceinline__ void norm_mod_row(const float* __restrict__ src, const float* __restrict__ g, const float* __restrict__ modrow,
                                             bf16_t* __restrict__ dst, int lane, int row) {
  float4 v[4];
  float ss = 0.f;
#pragma unroll
  for (int i = 0; i < 4; ++i) {
    v[i] = *(const float4*)(src + i * 256 + lane * 4);
    ss += v[i].x * v[i].x + v[i].y * v[i].y + v[i].z * v[i].z + v[i].w * v[i].w;
  }
  ss = wave_sum(ss);
  const float rstd = rsqrtf(ss * (1.0f / 1024.0f) + 1e-6f);
#pragma unroll
  for (int i = 0; i < 4; ++i) {
    const int c = i * 256 + lane * 4;
    const float4 gg = *(const float4*)(g + c);
    const float4 sh = *(const float4*)(modrow + c);
    const float4 sc = *(const float4*)(modrow + 1024 + c);
    const float o0 = v[i].x * rstd * gg.x * (1.0f + sc.x) + sh.x;
    const float o1 = v[i].y * rstd * gg.y * (1.0f + sc.y) + sh.y;
    const float o2 = v[i].z * rstd * gg.z * (1.0f + sc.z) + sh.z;
    const float o3 = v[i].w * rstd * gg.w * (1.0f + sc.w) + sh.w;
    uint2 pk;
    pk.x = (unsigned)f2bf(o0) | ((unsigned)f2bf(o1) << 16);
    pk.y = (unsigned)f2bf(o2) | ((unsigned)f2bf(o3) << 16);
    *(uint2*)(dst + kswz(row, c)) = pk;
  }
}

__device__ __forceinline__ void phase_h(const Params& p, int layer) {
  const int lane = threadIdx.x & 63, wave = threadIdx.x >> 6;
  const float* g = p.in[layer ? 23 : 4];
  const float* mod = (const float*)(p.ws + OFF_MOD) + layer * 33 * 3072;
  bf16_t* hbuf = (bf16_t*)(p.ws + OFF_RH);
  const float* xc1 = (const float*)(p.ws + OFF_XC1);
  for (int row = blockIdx.x * 4 + wave; row < NTOK; row += gridDim.x * 4) {
    const float* src; const float* modrow;
    if (row < NLAT) {
      const int b = row >> 11;
      modrow = mod + b * 3072;
      if (layer == 0) src = p.in[0] + (size_t)row * 1024;
      else {
        const int tp = row & 2047;
        const int t = (tp & 31) * 64 + (tp >> 5);
        src = p.out + ((size_t)b * 2048 + t) * 1024;
      }
    } else {
      modrow = mod + 32 * 3072;
      src = (layer == 0 ? p.in[2] : xc1) + (size_t)(row - NLAT) * 1024;
    }
    norm_mod_row(src, g, modrow, hbuf + (size_t)row * 1024, lane, row);
  }
}

__device__ __forceinline__ void phase_fnorm(const Params& p, char* smem) {
  const float* FILT = (const float*)(p.ws + OFF_FILT);
  float* fnorm = (float*)(p.ws + OFF_MISC);
  float* red = (float*)smem;
  const int tid = opaque_tid(), ci = tid & 7, ps = tid >> 3;
  for (int item = blockIdx.x; item < 64; item += gridDim.x) {
    const int c = item * 8 + ci;
    float s = 0.f;
    for (int q = ps; q < 4096; q += 32) s += fabsf(FILT[(size_t)q * 512 + c]);
    __syncthreads();
    red[ps * 8 + ci] = s;
    __syncthreads();
    if (tid < 8) {
      float t = 0.f;
      for (int i = 0; i < 32; ++i) t += red[i * 8 + tid];
      fnorm[item * 8 + tid] = t;
    }
  }
}

__device__ __forceinline__ void phase_kern(const Params& p) {
  const float* FILT = (const float*)(p.ws + OFF_FILT);
  const float* fnorm = (const float*)(p.ws + OFF_MISC);
  float* KERNT = (float*)(p.ws + OFF_KERN);
  for (int e = blockIdx.x * NTHREADS + threadIdx.x; e < 4096 * 512; e += gridDim.x * NTHREADS) {
    const int c = e >> 12, mi = e & 4095;
    const int m = mi - 2048;
    float v;
    if (mi == 0) v = 0.f;
    else if (m > 0) v = FILT[(size_t)m * 512 + c];
    else if (m < 0) v = FILT[((size_t)2048 + (-m)) * 512 + c];
    else v = FILT[c] + FILT[(size_t)2048 * 512 + c];
    KERNT[e] = v / fnorm[c];
  }
}

__device__ __forceinline__ bf16_t* out0_ptr(const Params& p, int branch, int dir, int row) {
  const int idx = branch * 2 + dir;
  if (row < NLAT) return (bf16_t*)((char*)p.out + (size_t)idx * 64 * MiB) + (size_t)row * 512;
  return (bf16_t*)(p.ws + OFF_CTXOUT + (size_t)idx * 8 * MiB) + (size_t)(row - NLAT) * 512;
}

using f32x4v = __attribute__((ext_vector_type(4))) float;
using bf16x4 = __attribute__((ext_vector_type(4))) short;
__device__ __forceinline__ bf16x8 pack8(const f32x16& a, int s2) {
  bf16x8 r;
#pragma unroll
  for (int j = 0; j < 8; ++j) r[j] = (short)f2bf(a[8 * s2 + j]);
  return r;
}
#define ML_QS 136
#define ML_TS 72
__device__ __forceinline__ void mlstm_chain(const Params& p, int chain, char* smem) {
  const int dir = chain & 1, h = (chain >> 1) & 3, b = chain >> 3;
  const bf16_t* U = (const bf16_t*)(p.ws + OFF_RU);
  const float* convw = p.in[9];
  const float* gate_b = p.in[10];
  bf16_t* Qs = (bf16_t*)smem;
  bf16_t* Ks = Qs + 64 * ML_QS;
  bf16_t* Ps = Ks;
  bf16_t* KgT = Ks + 64 * ML_QS;
  bf16_t* VT = KgT + 128 * ML_TS;
  float* sm = (float*)(VT + 128 * ML_TS);
  float* bcum = sm;
  float* eb = sm + 64;
  float* av = sm + 128;
  float* gs = sm + 192;
  float* denp = sm + 256;
  float* qnp = sm + 384;
  float* deni = sm + 640;
  float* nvec = sm + 704;
  float* scal = sm + 832;
  const int tid = opaque_tid(), lane = tid & 63, w = tid >> 6;
  const int fr = lane & 31, fh = lane >> 5;
  const int si = w >> 1, ti = w & 1;
  const int cc = tid & 127, which = tid >> 7;
  f32x16 Ct[4];
#pragma unroll
  for (int i = 0; i < 4; ++i)
#pragma unroll
    for (int r = 0; r < 16; ++r) Ct[i][r] = 0.f;
  __syncthreads();
  if (tid < 128) nvec[tid] = 0.f;
  const int ccol = (which == 0 ? C_MQ : C_MK) + h * 128 + cc;
  const float cw0 = convw[0 * 1024 + which * 512 + h * 128 + cc];
  const float cw1 = convw[1 * 1024 + which * 512 + h * 128 + cc];
  const float cw2 = convw[2 * 1024 + which * 512 + h * 128 + cc];
  const float kscale = (which == 0) ? 1.0f : 0.08838834764831845f;
  const float gbi = gate_b[dir * 8 + h], gbf = gate_b[dir * 8 + 4 + h];
  for (int seg = 0; seg < 2; ++seg) {
    const int L = seg ? 2048 : 256;
    const int rowbase = seg ? b * 2048 : NLAT + b * 256;
    for (int s0 = 0; s0 < L; s0 += 64) {
      const int tlo = dir ? (L - 64 - s0) : s0;
      if (w == 0) {
        const int t = tlo + (dir ? 63 - lane : lane);
        const size_t rb = (size_t)(rowbase + t) * LDU0 + C_MG + dir * 8 + h;
        const float ig = bf2f(U[rb]) + gbi;
        const float fg = bf2f(U[rb + 4]) + gbf;
        const float lf = -(fmaxf(-fg, 0.f) + __logf(1.0f + __expf(-fabsf(fg))));
        float bc = lf;
#pragma unroll
        for (int o = 1; o < 64; o <<= 1) {
          const float up = __shfl_up(bc, o, 64);
          if (lane >= o) bc += up;
        }
        const float bT = __shfl(bc, 63, 64);
        bcum[lane] = bc;
        eb[lane] = __expf(bc);
        av[lane] = ig - bc;
        gs[lane] = __expf(bT - bc + ig);
        if (lane == 0) scal[0] = __expf(bT);
      }
      __syncthreads();
      {
#pragma unroll 1
        for (int i0 = 0; i0 < 64; i0 += 8) {
          bf16_t xr[10];
#pragma unroll
          for (int r = 0; r < 10; ++r) {
            const int t = tlo + i0 - 1 + r;
            const int tc = min(max(t, 0), L - 1);
            xr[r] = U[(size_t)(rowbase + tc) * LDU0 + ccol];
          }
#pragma unroll
          for (int r = 0; r < 8; ++r) {
            const int i = i0 + r;
            const float xm = (tlo + i - 1 < 0) ? 0.f : bf2f(xr[r]);
            const float x0 = bf2f(xr[r + 1]);
            const float xp = (tlo + i + 1 >= L) ? 0.f : bf2f(xr[r + 2]);
            const float cv = cw0 * xm + cw1 * x0 + cw2 * xp;
            const float val = siluf_(cv) * kscale;
            const int li = dir ? 63 - i : i;
            if (which == 0) Qs[li * ML_QS + cc] = f2bf(val);
            else { Ks[li * ML_QS + cc] = f2bf(val); KgT[cc * ML_TS + li] = f2bf(val * gs[li]); }
          }
        }
#pragma unroll 1
        for (int q0 = 0; q0 < 32; q0 += 16) {
          bf16_t vr[16];
#pragma unroll
          for (int r = 0; r < 16; ++r) vr[r] = U[(size_t)(rowbase + tlo + which * 32 + q0 + r) * LDU0 + C_MV + h * 128 + cc];
#pragma unroll
          for (int r = 0; r < 16; ++r) {
            const int i = which * 32 + q0 + r;
            const int li = dir ? 63 - i : i;
            VT[cc * ML_TS + li] = vr[r];
          }
        }
      }
      __syncthreads();
      f32x16 sacc;
#pragma unroll
      for (int r = 0; r < 16; ++r) sacc[r] = 0.f;
      if (si <= ti) {
#pragma unroll
        for (int ks = 0; ks < 8; ++ks) {
          const bf16x8 a = *(const bf16x8*)(Ks + (si * 32 + fr) * ML_QS + ks * 16 + fh * 8);
          const bf16x8 bq = *(const bf16x8*)(Qs + (ti * 32 + fr) * ML_QS + ks * 16 + fh * 8);
          sacc = __builtin_amdgcn_mfma_f32_32x32x16_bf16(a, bq, sacc, 0, 0, 0);
        }
      }
      float dpart = 0.f;
      {
        const int t = ti * 32 + fr;
        const float bt = bcum[t];
#pragma unroll
        for (int r = 0; r < 16; ++r) {
          const int s_ = si * 32 + (r & 3) + 8 * (r >> 2) + 4 * fh;
          const float wgt = (s_ <= t && si <= ti) ? __expf(bt + av[s_]) : 0.f;
          sacc[r] *= wgt;
          dpart += sacc[r];
        }
        dpart += __shfl_xor(dpart, 32, 64);
      }
      {
        const int t = tid & 63, part = tid >> 6;
        float sq = 0.f;
#pragma unroll 8
        for (int d = part * 32; d < part * 32 + 32; ++d) sq = fmaf(bf2f(Qs[t * ML_QS + d]), nvec[d], sq);
        qnp[part * 64 + t] = sq;
      }
      __syncthreads();
      {
        const int t = ti * 32 + fr;
        if (si <= ti) {
#pragma unroll
          for (int g4 = 0; g4 < 4; ++g4) {
            uint2 pk;
            pk.x = (unsigned)f2bf(sacc[4 * g4 + 0]) | ((unsigned)f2bf(sacc[4 * g4 + 1]) << 16);
            pk.y = (unsigned)f2bf(sacc[4 * g4 + 2]) | ((unsigned)f2bf(sacc[4 * g4 + 3]) << 16);
            *(uint2*)(Ps + t * ML_TS + si * 32 + 8 * g4 + 4 * fh) = pk;
          }
        }
        if (fh == 0) denp[si * 64 + t] = dpart;
        if (si == 1 && fh == 1) denp[64 + fr] = 0.f;
      }
      const float ebT = scal[0];
      if (tid < 128) {
        float sn = 0.f;
#pragma unroll 8
        for (int s_ = 0; s_ < 64; ++s_) sn += bf2f(KgT[tid * ML_TS + s_]);
        nvec[tid] = ebT * nvec[tid] + sn;
      } else if (tid < 192) {
        const int t = tid - 128;
        deni[t] = eb[t] * (qnp[t] + qnp[64 + t] + qnp[128 + t] + qnp[192 + t]);
      }
      __syncthreads();
      if (tid < 64) {
        const float den = denp[tid] + denp[64 + tid] + deni[tid];
        qnp[tid] = 1.0f / fmaxf(fabsf(den), 1.0f);
      }
      __syncthreads();
      bf16_t* obase = (seg ? (bf16_t*)((char*)p.out + (size_t)dir * 64 * MiB) + (size_t)b * 2048 * 512
                           : (bf16_t*)(p.ws + OFF_CTXOUT + (size_t)dir * 8 * MiB) + (size_t)b * 256 * 512) + h * 128 + w * 32;
#pragma unroll 1
      for (int t2 = 0; t2 < 2; ++t2) {
        f32x16 num;
#pragma unroll
        for (int r = 0; r < 16; ++r) num[r] = 0.f;
#pragma unroll
        for (int di = 0; di < 4; ++di)
#pragma unroll
          for (int s2 = 0; s2 < 2; ++s2) {
            const int d0 = di * 32 + 16 * s2;
            const bf16x4 qa = *(const bf16x4*)(Qs + (t2 * 32 + fr) * ML_QS + d0 + 4 * fh);
            const bf16x4 qb = *(const bf16x4*)(Qs + (t2 * 32 + fr) * ML_QS + d0 + 8 + 4 * fh);
            bf16x8 a;
            a[0] = qa[0]; a[1] = qa[1]; a[2] = qa[2]; a[3] = qa[3];
            a[4] = qb[0]; a[5] = qb[1]; a[6] = qb[2]; a[7] = qb[3];
            num = __builtin_amdgcn_mfma_f32_32x32x16_bf16(a, pack8(Ct[di], s2), num, 0, 0, 0);
            __builtin_amdgcn_sched_barrier(0);
          }
#pragma unroll
        for (int r = 0; r < 16; ++r) num[r] *= eb[t2 * 32 + (r & 3) + 8 * (r >> 2) + 4 * fh];
        const int nks = 2 * (t2 + 1);
        for (int ks = 0; ks < nks; ++ks) {
          const bf16x8 a = *(const bf16x8*)(Ps + (t2 * 32 + fr) * ML_TS + ks * 16 + fh * 8);
          const bf16x8 bv = *(const bf16x8*)(VT + (w * 32 + fr) * ML_TS + ks * 16 + fh * 8);
          num = __builtin_amdgcn_mfma_f32_32x32x16_bf16(a, bv, num, 0, 0, 0);
        }
#pragma unroll
        for (int r = 0; r < 16; ++r) {
          const int t = t2 * 32 + (r & 3) + 8 * (r >> 2) + 4 * fh;
          const float hv = num[r] * qnp[t];
          const int tok = tlo + (dir ? 63 - t : t);
          obase[(unsigned)(tok * 512 + fr)] = f2bf(hv);
        }
      }
#pragma unroll
      for (int di = 0; di < 4; ++di) {
#pragma unroll
        for (int r = 0; r < 16; ++r) Ct[di][r] *= ebT;
#pragma unroll
        for (int ks = 0; ks < 4; ++ks) {
          const bf16x8 a = *(const bf16x8*)(KgT + (di * 32 + fr) * ML_TS + ks * 16 + fh * 8);
          const bf16x8 bv = *(const bf16x8*)(VT + (w * 32 + fr) * ML_TS + ks * 16 + fh * 8);
          Ct[di] = __builtin_amdgcn_mfma_f32_32x32x16_bf16(a, bv, Ct[di], 0, 0, 0);
        }
        __builtin_amdgcn_sched_barrier(0);
      }
      __syncthreads();
    }
  }
}

#define RW_LBAR() { asm volatile("s_waitcnt lgkmcnt(0)" ::: "memory"); __builtin_amdgcn_s_barrier(); asm volatile("" ::: "memory"); }
__device__ __forceinline__ bf16x8 cat44(bf16x4 lo, bf16x4 hi) {
  bf16x8 r;
  r[0] = lo[0]; r[1] = lo[1]; r[2] = lo[2]; r[3] = lo[3]; r[4] = hi[0]; r[5] = hi[1]; r[6] = hi[2]; r[7] = hi[3];
  return r;
}
__device__ __forceinline__ bf16x8 pk4z(const f32x4v& a) {
  bf16x8 r;
  r[0] = (short)f2bf(a[0]); r[1] = (short)f2bf(a[1]); r[2] = (short)f2bf(a[2]); r[3] = (short)f2bf(a[3]);
  r[4] = 0; r[5] = 0; r[6] = 0; r[7] = 0;
  return r;
}
__device__ __forceinline__ void rwkv_chain(const Params& p, int chain, char* smem) {
  const int dir = chain & 1, h = (chain >> 1) & 7, b = chain >> 4;
  const bf16_t* U = (const bf16_t*)(p.ws + OFF_RU);
  bf16_t* RAWb = (bf16_t*)smem;
  bf16_t* TW = RAWb + 18 * 320;
  bf16_t* ADi = TW + 16 * 72;
  bf16_t* WupT = ADi + 16 * 72;
  bf16_t* AupT = WupT + 64 * 72;
  bf16_t* At = AupT + 64 * 72;
  bf16_t* Bt = At + 16 * 72;
  bf16_t* Kt = Bt + 16 * 72;
  bf16_t* Rt = Kt + 16 * 72;
  bf16_t* BKh = Rt + 16 * 72;
  bf16_t* UT = BKh + 64 * 40;
  bf16_t* LakI = UT + 64 * 40;
  bf16_t* MrbI = LakI + 16 * 40;
  bf16_t* MrkI = MrbI + 16 * 40;
  bf16_t* TinvI = MrkI + 16 * 40;
  float* Wd = (float*)(TinvI + 16 * 40);
  float* Av = Wd + 1024;
  float* Vf = Av + 1024;
  float* Lab = Vf + 1024;
  float* COEF = Lab + 272;
  float* WTs = COEF + 16;
  const int tid = opaque_tid(), lane = tid & 63, w = tid >> 6;
  const int c16 = lane & 15, q4 = lane >> 4;
  const int j = tid & 63, tg = tid >> 6;
  const int hj = h * 64 + j;
  const int jw = h * 64 + 16 * w + c16;
  __syncthreads();
  for (int e = tid; e < 64 * 40; e += NTHREADS) UT[e] = 0;
  for (int e = tid; e < 4 * 16 * 40; e += NTHREADS) LakI[e] = 0;
  for (int e = tid; e < 4096; e += NTHREADS) {
    const int r = e >> 6, jj = e & 63;
    WupT[jj * 72 + r] = f2bf(p.in[14][((size_t)dir * 64 + r) * 512 + h * 64 + jj]);
    AupT[jj * 72 + r] = f2bf(p.in[16][((size_t)dir * 64 + r) * 512 + h * 64 + jj]);
  }
  const float mu0 = p.in[12][hj], mu1 = p.in[12][512 + hj], mu2 = p.in[12][1024 + hj];
  const float k_k = p.in[17][hj], k_a = p.in[18][hj], r_k = p.in[19][hj];
  const float w0 = p.in[13][dir * 512 + jw], a0 = p.in[15][dir * 512 + jw];
  f32x4v STt[4];
#pragma unroll
  for (int i = 0; i < 4; ++i) { STt[i][0] = 0.f; STt[i][1] = 0.f; STt[i][2] = 0.f; STt[i][3] = 0.f; }
  uint4 PF[3];
#define RWC_PREFETCH(ci_) { \
    const int seg_ = (ci_) >= 16; const int L_ = seg_ ? 2048 : 256; \
    const int rb_ = seg_ ? b * 2048 : NLAT + b * 256; \
    const int s0_ = (seg_ ? (ci_) - 16 : (ci_)) * 16; \
    const int tl_ = dir ? (L_ - 16 - s0_) : s0_; \
    _Pragma("unroll") for (int q = 0; q < 3; ++q) { \
      const int cid = min(tid + 256 * q, 719); \
      const int row = cid / 40, cc = cid - row * 40; \
      const int arr = cc >> 3, part = cc & 7; \
      const int t_ = tl_ - 1 + row; \
      const int tc_ = min(max(t_, 0), L_ - 1); \
      const int col = ((arr == 0) ? (C_RR + h * 64) : (arr == 1) ? (C_RK + h * 64) : (arr == 2) ? (C_RV + h * 64) : (arr == 3) ? (C_WD + dir * 64) : (C_AD + dir * 64)) + part * 8; \
      uint4 v_ = *(const uint4*)(U + (size_t)(rb_ + tc_) * LDU0 + col); \
      if (t_ < 0 || t_ >= L_) v_ = make_uint4(0u, 0u, 0u, 0u); \
      PF[q] = v_; \
    } }
  RWC_PREFETCH(0)
  for (int ci = 0; ci < 144; ++ci) {
    const int seg = ci >= 16;
    const int L = seg ? 2048 : 256;
    const int s0 = (seg ? ci - 16 : ci) * 16;
    const int tlo = dir ? (L - 16 - s0) : s0;
#pragma unroll
    for (int q = 0; q < 3; ++q) {
      const int cid = tid + 256 * q;
      if (cid < 720) {
        const int row = cid / 40, cc = cid - row * 40;
        *(uint4*)(RAWb + row * 320 + cc * 8) = PF[q];
      }
    }
    RW_LBAR()
    if (ci + 1 < 144) RWC_PREFETCH(ci + 1)
    {
      const int li = tid >> 4, r4 = tid & 15;
      const int itok = dir ? 15 - li : li;
      const bf16x4 wv = *(const bf16x4*)(RAWb + (itok + 1) * 320 + 3 * 64 + r4 * 4);
      const bf16x4 avv = *(const bf16x4*)(RAWb + (itok + 1) * 320 + 4 * 64 + r4 * 4);
      bf16x4 tw;
#pragma unroll
      for (int i = 0; i < 4; ++i) tw[i] = (short)f2bf(tanh_fast(bf2f((bf16_t)wv[i])));
      *(bf16x4*)(TW + li * 72 + r4 * 4) = tw;
      *(bf16x4*)(ADi + li * 72 + r4 * 4) = avv;
    }
    RW_LBAR()
    {
      f32x4v accw = {0.f, 0.f, 0.f, 0.f}, acca = {0.f, 0.f, 0.f, 0.f};
#pragma unroll
      for (int ks = 0; ks < 2; ++ks) {
        const bf16x8 a1 = *(const bf16x8*)(TW + c16 * 72 + ks * 32 + q4 * 8);
        const bf16x8 bw = *(const bf16x8*)(WupT + (16 * w + c16) * 72 + ks * 32 + q4 * 8);
        accw = __builtin_amdgcn_mfma_f32_16x16x32_bf16(a1, bw, accw, 0, 0, 0);
        const bf16x8 a2 = *(const bf16x8*)(ADi + c16 * 72 + ks * 32 + q4 * 8);
        const bf16x8 ba = *(const bf16x8*)(AupT + (16 * w + c16) * 72 + ks * 32 + q4 * 8);
        acca = __builtin_amdgcn_mfma_f32_16x16x32_bf16(a2, ba, acca, 0, 0, 0);
      }
      float cp[4];
#pragma unroll
      for (int r = 0; r < 4; ++r) {
        const int li = 4 * q4 + r;
        const float xw = -(w0 + accw[r]);
        const float sp = fmaxf(xw, 0.f) + __logf(1.0f + __expf(-fabsf(xw)));
        const float dcy = __expf(-__expf(-sp - 0.5f));
        cp[r] = (r == 0) ? dcy : cp[r - 1] * dcy;
        Av[li * 64 + 16 * w + c16] = sigmoidf_(a0 + acca[r]);
      }
      const float t1 = __shfl_up(cp[3], 16, 64), t2 = __shfl_up(cp[3], 32, 64), t3 = __shfl_up(cp[3], 48, 64);
      const float pre = ((q4 >= 1) ? t1 : 1.0f) * ((q4 >= 2) ? t2 : 1.0f) * ((q4 >= 3) ? t3 : 1.0f);
#pragma unroll
      for (int r = 0; r < 4; ++r) Wd[(4 * q4 + r) * 64 + 16 * w + c16] = pre * cp[r];
      if (q4 == 3) WTs[16 * w + c16] = pre * cp[3];
    }
    RW_LBAR()
    {
      const float WTj = WTs[j];
#pragma unroll
      for (int i = 0; i < 4; ++i) {
        const int li = tg * 4 + i;
        const int itok = dir ? 15 - li : li;
        const bf16_t* rp = RAWb + itok * 320;
        const bf16_t* rc = rp + 320;
        const bf16_t* rn = rc + 320;
        const float rrc = bf2f(rc[j]), krc = bf2f(rc[64 + j]), vvc = bf2f(rc[128 + j]);
        const float rr = rrc + mu0 * (0.5f * (bf2f(rp[j]) + bf2f(rn[j])) - rrc);
        const float kr = krc + mu1 * (0.5f * (bf2f(rp[64 + j]) + bf2f(rn[64 + j])) - krc);
        const float vv = vvc + mu2 * (0.5f * (bf2f(rp[128 + j]) + bf2f(rn[128 + j])) - vvc);
        const float av = Av[li * 64 + j];
        const float kkraw = kr * k_k;
        const float ss = wave_sum(kkraw * kkraw);
        const float kk = kkraw * __builtin_amdgcn_rsqf(fmaxf(ss, 1e-24f));
        const float kt = kr * (1.0f + (av - 1.0f) * k_a);
        const float coef = wave_sum(rr * kt * r_k);
        const float bv = kk * av;
        const float Wc = Wd[li * 64 + j];
        const float Wp = (li > 0) ? Wd[(li - 1) * 64 + j] : 1.0f;
        const float iW = frcp_(Wc);
        At[li * 72 + j] = f2bf(-kk * Wp);
        Bt[li * 72 + j] = f2bf(bv * iW);
        Kt[li * 72 + j] = f2bf(kt * iW);
        Rt[li * 72 + j] = f2bf(rr * Wc);
        BKh[j * 40 + li] = f2bf(bv * iW * WTj);
        BKh[j * 40 + 16 + li] = f2bf(kt * iW * WTj);
        UT[j * 40 + li] = f2bf(vv);
        Vf[li * 64 + j] = vv;
        if (j == 0) COEF[li] = coef;
      }
    }
    RW_LBAR()
    {
      const bf16_t* X = (w < 2) ? At : Rt;
      const bf16_t* Yt = (w & 1) ? Kt : Bt;
      f32x4v acc = {0.f, 0.f, 0.f, 0.f};
#pragma unroll
      for (int ks = 0; ks < 2; ++ks) {
        const bf16x8 a = *(const bf16x8*)(X + c16 * 72 + ks * 32 + q4 * 8);
        const bf16x8 bb = *(const bf16x8*)(Yt + c16 * 72 + ks * 32 + q4 * 8);
        acc = __builtin_amdgcn_mfma_f32_16x16x32_bf16(a, bb, acc, 0, 0, 0);
      }
      bf16_t* img = (w == 1) ? LakI : (w == 2) ? MrbI : MrkI;
#pragma unroll
      for (int r = 0; r < 4; ++r) {
        const int t = 4 * q4 + r, s_ = c16;
        const bool keep = (w < 2) ? (s_ < t) : (s_ <= t);
        const float val = keep ? acc[r] : 0.f;
        if (w == 0) Lab[t * 17 + s_] = val;
        else img[t * 40 + s_] = f2bf(val);
      }
    }
    RW_LBAR()
    if (w == 0) {
      float x[16];
#pragma unroll
      for (int t = 0; t < 16; ++t) {
        float sx = (t == c16) ? 1.0f : 0.f;
#pragma unroll
        for (int s_ = 0; s_ < t; ++s_) sx = fmaf(Lab[t * 17 + s_], x[s_], sx);
        x[t] = sx;
      }
      if (q4 == 0) {
#pragma unroll
        for (int t = 0; t < 16; ++t) TinvI[t * 40 + c16] = f2bf(x[t]);
      }
    }
    bf16x8 stB[2];
#pragma unroll
    for (int s2 = 0; s2 < 2; ++s2)
#pragma unroll
      for (int i = 0; i < 4; ++i) { stB[s2][i] = (short)f2bf(STt[2 * s2][i]); stB[s2][4 + i] = (short)f2bf(STt[2 * s2 + 1][i]); }
    const bf16x8 ufrag = *(const bf16x8*)(UT + (16 * w + c16) * 40 + 8 * q4);
    f32x4v rhs = {0.f, 0.f, 0.f, 0.f}, y = {0.f, 0.f, 0.f, 0.f};
#pragma unroll
    for (int s2 = 0; s2 < 2; ++s2) {
      const bf16x8 aa = cat44(*(const bf16x4*)(At + c16 * 72 + 32 * s2 + 4 * q4), *(const bf16x4*)(At + c16 * 72 + 32 * s2 + 16 + 4 * q4));
      rhs = __builtin_amdgcn_mfma_f32_16x16x32_bf16(aa, stB[s2], rhs, 0, 0, 0);
      const bf16x8 ra = cat44(*(const bf16x4*)(Rt + c16 * 72 + 32 * s2 + 4 * q4), *(const bf16x4*)(Rt + c16 * 72 + 32 * s2 + 16 + 4 * q4));
      y = __builtin_amdgcn_mfma_f32_16x16x32_bf16(ra, stB[s2], y, 0, 0, 0);
    }
    rhs = __builtin_amdgcn_mfma_f32_16x16x32_bf16(*(const bf16x8*)(LakI + c16 * 40 + 8 * q4), ufrag, rhs, 0, 0, 0);
    y = __builtin_amdgcn_mfma_f32_16x16x32_bf16(*(const bf16x8*)(MrkI + c16 * 40 + 8 * q4), ufrag, y, 0, 0, 0);
    RW_LBAR()
    {
      const bf16x4 z4 = {0, 0, 0, 0};
      const bf16x8 tfrag = cat44(*(const bf16x4*)(TinvI + c16 * 40 + 4 * q4), z4);
      f32x4v Cc = {0.f, 0.f, 0.f, 0.f};
      Cc = __builtin_amdgcn_mfma_f32_16x16x32_bf16(tfrag, pk4z(rhs), Cc, 0, 0, 0);
      const bf16x8 mfrag = cat44(*(const bf16x4*)(MrbI + c16 * 40 + 4 * q4), z4);
      y = __builtin_amdgcn_mfma_f32_16x16x32_bf16(mfrag, pk4z(Cc), y, 0, 0, 0);
      bf16_t* obase = (seg ? (bf16_t*)((char*)p.out + (size_t)(2 + dir) * 64 * MiB) + (size_t)b * 2048 * 512
                           : (bf16_t*)(p.ws + OFF_CTXOUT + (size_t)(2 + dir) * 8 * MiB) + (size_t)b * 256 * 512) + h * 64 + 16 * w;
#pragma unroll
      for (int r = 0; r < 4; ++r) {
        const int li = 4 * q4 + r;
        const int tok = tlo + (dir ? 15 - li : li);
        const float val = y[r] + COEF[li] * Vf[li * 64 + 16 * w + c16];
        obase[(unsigned)(tok * 512 + c16)] = f2bf(val);
      }
      bf16x8 cuB = pk4z(Cc);
#pragma unroll
      for (int i = 0; i < 4; ++i) cuB[4 + i] = (short)f2bf(Vf[(4 * q4 + i) * 64 + 16 * w + c16]);
#pragma unroll
      for (int kt = 0; kt < 4; ++kt) {
#pragma unroll
        for (int r = 0; r < 4; ++r) STt[kt][r] *= WTs[16 * kt + 4 * q4 + r];
        const bf16x8 af = cat44(*(const bf16x4*)(BKh + (16 * kt + c16) * 40 + 4 * q4), *(const bf16x4*)(BKh + (16 * kt + c16) * 40 + 16 + 4 * q4));
        STt[kt] = __builtin_amdgcn_mfma_f32_16x16x32_bf16(af, cuB, STt[kt], 0, 0, 0);
      }
    }
    RW_LBAR()
  }
  __syncthreads();
}

__device__ __forceinline__ void fast_grid_barrier(unsigned* base, unsigned k) {
  __syncthreads();
  if (threadIdx.x == 0) {
    __builtin_amdgcn_fence(__ATOMIC_RELEASE, "agent");
    const unsigned g = blockIdx.x & 7u;
    const unsigned ng = (gridDim.x - g + 7u) >> 3;
    const unsigned old = __hip_atomic_fetch_add(base + g * 32, 1u, __ATOMIC_RELAXED, __HIP_MEMORY_SCOPE_AGENT);
    if (old == k * ng - 1u) {
      __threadfence();
      const unsigned t = __hip_atomic_fetch_add(base + 8 * 32, 1u, __ATOMIC_RELAXED, __HIP_MEMORY_SCOPE_AGENT);
      if (t == k * 8u - 1u) {
        __threadfence();
#pragma unroll
        for (int i = 0; i < 8; ++i) __hip_atomic_store(base + (9 + i) * 32, k, __ATOMIC_RELAXED, __HIP_MEMORY_SCOPE_AGENT);
      }
    }
    while (__hip_atomic_load(base + (9 + g) * 32, __ATOMIC_RELAXED, __HIP_MEMORY_SCOPE_AGENT) < k) __builtin_amdgcn_s_sleep(2);
    __builtin_amdgcn_fence(__ATOMIC_ACQUIRE, "agent");
  }
  __syncthreads();
}

__device__ __forceinline__ int next_item(int* counter, int* s_item) {
  __syncthreads();
  if (threadIdx.x == 0) *s_item = atomicAdd(counter, 1);
  __syncthreads();
  return *s_item;
}

__device__ __forceinline__ void phase_scan0(const Params& p, char* smem, int* s_item, int rep) {
  int* ctr = (int*)(p.ws + OFF_MISC + 4096) + 2 * rep;
  bool run_m = true, run_r = true;
#if PROBE_PHASE == 3
  if (rep == 0 && p.ph_hi == 13) { if (PROBE_SUB == 1) run_r = false; else run_m = false; }
#endif
  int item = next_item(ctr, s_item);
  while (item < 256) { if (run_m) mlstm_chain(p, item, smem); item = next_item(ctr, s_item); }
  while (item < 768) { if (run_r) rwkv_chain(p, item - 256, smem); item = next_item(ctr, s_item); }
}

__device__ __forceinline__ void ld8(const bf16_t* ptr, float* o) {
  const uint4 r = *(const uint4*)ptr;
  o[0] = __uint_as_float(r.x << 16); o[1] = __uint_as_float(r.x & 0xffff0000u);
  o[2] = __uint_as_float(r.y << 16); o[3] = __uint_as_float(r.y & 0xffff0000u);
  o[4] = __uint_as_float(r.z << 16); o[5] = __uint_as_float(r.z & 0xffff0000u);
  o[6] = __uint_as_float(r.w << 16); o[7] = __uint_as_float(r.w & 0xffff0000u);
}
__device__ __forceinline__ void st8(bf16_t* ptr, const float* v) {
  uint4 r;
  r.x = (unsigned)f2bf(v[0]) | ((unsigned)f2bf(v[1]) << 16);
  r.y = (unsigned)f2bf(v[2]) | ((unsigned)f2bf(v[3]) << 16);
  r.z = (unsigned)f2bf(v[4]) | ((unsigned)f2bf(v[5]) << 16);
  r.w = (unsigned)f2bf(v[6]) | ((unsigned)f2bf(v[7]) << 16);
  *(uint4*)ptr = r;
}

__device__ __forceinline__ void phase_finish0(const Params& p) {
  const int lane = threadIdx.x & 63, wave = threadIdx.x >> 6;
  const bf16_t* U = (const bf16_t*)(p.ws + OFF_RU);
  bf16_t* mix = (bf16_t*)(p.ws + OFF_RH);
  const float* mng = p.in[11];
  const float* lnw = p.in[20];
  const float* lnb = p.in[21];
  const int c0 = lane * 8;
  for (int row = blockIdx.x * 4 + wave; row < NTOK; row += gridDim.x * 4) {
    const bf16_t* urow = U + (size_t)row * LDU0;
    float a[8], bb[8], o[8], z[8], y[8];
    ld8(out0_ptr(p, 0, 0, row) + c0, a);
    ld8(out0_ptr(p, 0, 1, row) + c0, bb);
    ld8(urow + C_MO + c0, o);
    ld8(urow + C_MZ + c0, z);
    float ss = 0.f;
#pragma unroll
    for (int i = 0; i < 8; ++i) { a[i] += bb[i]; ss += a[i] * a[i]; }
#pragma unroll
    for (int of = 1; of < 16; of <<= 1) ss += __shfl_xor(ss, of, 64);
    const float rstd = rsqrtf(ss * (1.0f / 128.0f) + 1e-6f);
#pragma unroll
    for (int i = 0; i < 8; ++i) y[i] = a[i] * rstd * mng[c0 + i] * sigmoidf_(o[i]) * siluf_(z[i]);
    st8(mix + (size_t)row * 1024 + kswz(row, c0), y);
    ld8(out0_ptr(p, 1, 0, row) + c0, a);
    ld8(out0_ptr(p, 1, 1, row) + c0, bb);
    ld8(urow + C_RZ + c0, z);
    float sm = 0.f;
#pragma unroll
    for (int i = 0; i < 8; ++i) { a[i] += bb[i]; sm += a[i]; }
#pragma unroll
    for (int of = 1; of < 8; of <<= 1) sm += __shfl_xor(sm, of, 64);
    const float mu = sm * (1.0f / 64.0f);
    float sv = 0.f;
#pragma unroll
    for (int i = 0; i < 8; ++i) { a[i] -= mu; sv += a[i] * a[i]; }
#pragma unroll
    for (int of = 1; of < 8; of <<= 1) sv += __shfl_xor(sv, of, 64);
    const float rs = rsqrtf(sv * (1.0f / 64.0f) + 64e-5f);
#pragma unroll
    for (int i = 0; i < 8; ++i) y[i] = (a[i] * rs * lnw[c0 + i] + lnb[c0 + i]) * siluf_(z[i]);
    st8(mix + (size_t)row * 1024 + kswz(row, 512 + c0), y);
  }
}

__device__ __forceinline__ void phase_hyprep(const Params& p, char* smem) {
  const bf16_t* U = (const bf16_t*)(p.ws + OFF_RU);
  bf16_t* UT = (bf16_t*)(p.ws + OFF_UHY);
  bf16_t* GT = (bf16_t*)(p.ws + OFF_GHY);
  const float* sw = p.in[29];
  const float* sb = p.in[30];
  bf16_t* Tu = (bf16_t*)smem;
  bf16_t* Tg = Tu + 64 * 72;
  const int tid = opaque_tid(), cg = tid & 7, tkb = tid >> 3;
  for (int item = blockIdx.x; item < 8192; item += gridDim.x) {
    const int ct = item & 7, tt = (item >> 3) & 31, b = item >> 8;
    const int t0 = tt * 64, c0 = ct * 64 + cg * 8;
    __syncthreads();
#pragma unroll 1
    for (int ps = 0; ps < 2; ++ps) {
      const int tk = tkb + ps * 32;
      const int tp = t0 + tk;
      const bf16_t* uc = U + (size_t)(b * 2048 + tp) * LDU1;
      float sv[3][8];
#pragma unroll
      for (int part = 0; part < 3; ++part) {
        const int col = C_YV + part * 512 + c0;
        float xm[8], x0[8], xp[8];
        ld8(uc + col, x0);
        ld8(uc + (tp > 0 ? -LDU1 : 0) + col, xm);
        ld8(uc + (tp < 2047 ? LDU1 : 0) + col, xp);
#pragma unroll
        for (int i = 0; i < 8; ++i) {
          const int cc = part * 512 + c0 + i;
          const float a = (tp > 0) ? xm[i] : 0.f;
          const float c = (tp < 2047) ? xp[i] : 0.f;
          sv[part][i] = a * sw[cc] + x0[i] * sw[1536 + cc] + c * sw[3072 + cc] + sb[cc];
        }
      }
      float z[8];
      ld8(uc + C_YZ + c0, z);
#pragma unroll
      for (int i = 0; i < 8; ++i) {
        Tu[(cg * 8 + i) * 72 + tk] = f2bf(sv[2][i] * sv[0][i]);
        Tg[(cg * 8 + i) * 72 + tk] = f2bf(sv[1][i] * siluf_(z[i]));
      }
    }
    __syncthreads();
    {
      const int cl = tid >> 2, part = tid & 3;
      const size_t dst = ((size_t)(ct * 64 + cl) * 32 + b) * 2048 + t0 + part * 16;
      const uint4 u0 = *(const uint4*)(Tu + cl * 72 + part * 16), u1 = *(const uint4*)(Tu + cl * 72 + part * 16 + 8);
      const uint4 g0 = *(const uint4*)(Tg + cl * 72 + part * 16), g1 = *(const uint4*)(Tg + cl * 72 + part * 16 + 8);
      *(uint4*)(UT + dst) = u0; *(uint4*)(UT + dst + 8) = u1;
      *(uint4*)(GT + dst) = g0; *(uint4*)(GT + dst + 8) = g1;
    }
  }
  __syncthreads();
}

__device__ __forceinline__ void hgrn_chain(const Params& p, int chain, char* smem) {
  const int dir = chain & 1, h = (chain >> 1) & 3, b = chain >> 3;
  const bf16_t* U = (const bf16_t*)(p.ws + OFF_RU);
  bf16_t* Qs = (bf16_t*)smem;
  bf16_t* Ks = Qs + 64 * ML_QS;
  bf16_t* Ps = Ks;
  bf16_t* KgT = Ks + 64 * ML_QS;
  bf16_t* VT = KgT + 128 * ML_TS;
  float* sm = (float*)(VT + 128 * ML_TS);
  float* ebT = sm;
  const int tid = opaque_tid(), lane = tid & 63, w = tid >> 6;
  const int fr = lane & 31, fh = lane >> 5;
  const int si = w >> 1, ti = w & 1;
  const int cc = tid & 127, which = tid >> 7;
  const int ch = h * 128 + cc;
  const float lb = sigmoidf_(p.in[22][512 + ch] - p.in[22][ch]);
  f32x16 Ct[4];
#pragma unroll
  for (int i = 0; i < 4; ++i)
#pragma unroll
    for (int r = 0; r < 16; ++r) Ct[i][r] = 0.f;
  __syncthreads();
  for (int seg = 0; seg < 2; ++seg) {
    const int L = seg ? 2048 : 256;
    const int rowbase = seg ? b * 2048 : NLAT + b * 256;
    for (int s0 = 0; s0 < L; s0 += 64) {
      const int tlo = dir ? (L - 64 - s0) : s0;
      if (which == 0) {
        float P = 1.0f;
#pragma unroll 1
        for (int l0 = 0; l0 < 64; l0 += 32) {
          bf16_t qr[32], fr_[32];
#pragma unroll
          for (int r = 0; r < 32; ++r) {
            const int li = l0 + r;
            const int t = dir ? tlo + 63 - li : tlo + li;
            const bf16_t* up = U + (size_t)(rowbase + t) * LDU1 + ch;
            qr[r] = up[C_GQ];
            fr_[r] = up[C_GF + dir * 512];
          }
#pragma unroll
          for (int r = 0; r < 32; ++r) {
            const int li = l0 + r;
            const float q = bf2f(qr[r]);
            const float ff = bf2f(fr_[r]);
            const float f = lb + (1.0f - lb) * sigmoidf_(ff);
            const float kk = (1.0f - lb) * sigmoidf_(-ff);
            P *= f;
            Qs[li * ML_QS + cc] = f2bf(q * P);
            Ks[li * ML_QS + cc] = f2bf(kk * frcp_(P));
          }
        }
        ebT[cc] = P;
#pragma unroll 4
        for (int li = 0; li < 64; ++li) KgT[cc * ML_TS + li] = f2bf(bf2f(Ks[li * ML_QS + cc]) * P);
      } else {
#pragma unroll 1
        for (int l0 = 0; l0 < 64; l0 += 32) {
          bf16_t vr[32];
#pragma unroll
          for (int r = 0; r < 32; ++r) {
            const int li = l0 + r;
            const int t = dir ? tlo + 63 - li : tlo + li;
            vr[r] = U[(size_t)(rowbase + t) * LDU1 + C_GI + ch];
          }
#pragma unroll
          for (int r = 0; r < 32; ++r) VT[cc * ML_TS + l0 + r] = vr[r];
        }
      }
      __syncthreads();
      f32x16 sacc;
#pragma unroll
      for (int r = 0; r < 16; ++r) sacc[r] = 0.f;
      if (si <= ti) {
#pragma unroll
        for (int ks = 0; ks < 8; ++ks) {
          const bf16x8 a = *(const bf16x8*)(Ks + (si * 32 + fr) * ML_QS + ks * 16 + fh * 8);
          const bf16x8 bq = *(const bf16x8*)(Qs + (ti * 32 + fr) * ML_QS + ks * 16 + fh * 8);
          sacc = __builtin_amdgcn_mfma_f32_32x32x16_bf16(a, bq, sacc, 0, 0, 0);
        }
      }
      __syncthreads();
      if (si <= ti) {
        const int t = ti * 32 + fr;
#pragma unroll
        for (int g4 = 0; g4 < 4; ++g4) {
          float pv[4];
#pragma unroll
          for (int i = 0; i < 4; ++i) {
            const int s_ = si * 32 + 8 * g4 + 4 * fh + i;
            pv[i] = (s_ <= t) ? sacc[4 * g4 + i] : 0.f;
          }
          uint2 pk;
          pk.x = (unsigned)f2bf(pv[0]) | ((unsigned)f2bf(pv[1]) << 16);
          pk.y = (unsigned)f2bf(pv[2]) | ((unsigned)f2bf(pv[3]) << 16);
          *(uint2*)(Ps + t * ML_TS + si * 32 + 8 * g4 + 4 * fh) = pk;
        }
      }
      __syncthreads();
      bf16_t* obase = (bf16_t*)(p.ws + OFF_RH) + (size_t)dir * NLAT * 512 + (size_t)b * 2048 * 512 + h * 128 + w * 32;
#pragma unroll 1
      for (int t2 = 0; t2 < 2; ++t2) {
        f32x16 num;
#pragma unroll
        for (int r = 0; r < 16; ++r) num[r] = 0.f;
#pragma unroll
        for (int di = 0; di < 4; ++di)
#pragma unroll
          for (int s2 = 0; s2 < 2; ++s2) {
            const int d0 = di * 32 + 16 * s2;
            const bf16x4 qa = *(const bf16x4*)(Qs + (t2 * 32 + fr) * ML_QS + d0 + 4 * fh);
            const bf16x4 qb = *(const bf16x4*)(Qs + (t2 * 32 + fr) * ML_QS + d0 + 8 + 4 * fh);
            bf16x8 a;
            a[0] = qa[0]; a[1] = qa[1]; a[2] = qa[2]; a[3] = qa[3];
            a[4] = qb[0]; a[5] = qb[1]; a[6] = qb[2]; a[7] = qb[3];
            num = __builtin_amdgcn_mfma_f32_32x32x16_bf16(a, pack8(Ct[di], s2), num, 0, 0, 0);
            __builtin_amdgcn_sched_barrier(0);
          }
        const int nks = 2 * (t2 + 1);
        for (int ks = 0; ks < nks; ++ks) {
          const bf16x8 a = *(const bf16x8*)(Ps + (t2 * 32 + fr) * ML_TS + ks * 16 + fh * 8);
          const bf16x8 bv = *(const bf16x8*)(VT + (w * 32 + fr) * ML_TS + ks * 16 + fh * 8);
          num = __builtin_amdgcn_mfma_f32_32x32x16_bf16(a, bv, num, 0, 0, 0);
        }
        if (seg) {
#pragma unroll
          for (int r = 0; r < 16; ++r) {
            const int t = t2 * 32 + (r & 3) + 8 * (r >> 2) + 4 * fh;
            const int tok = tlo + (dir ? 63 - t : t);
            obase[(unsigned)(tok * 512 + fr)] = f2bf(num[r]);
          }
        }
      }
#pragma unroll
      for (int di = 0; di < 4; ++di) {
#pragma unroll
        for (int r = 0; r < 16; ++r) Ct[di][r] *= ebT[di * 32 + (r & 3) + 8 * (r >> 2) + 4 * fh];
#pragma unroll
        for (int ks = 0; ks < 4; ++ks) {
          const bf16x8 a = *(const bf16x8*)(KgT + (di * 32 + fr) * ML_TS + ks * 16 + fh * 8);
          const bf16x8 bv = *(const bf16x8*)(VT + (w * 32 + fr) * ML_TS + ks * 16 + fh * 8);
          Ct[di] = __builtin_amdgcn_mfma_f32_32x32x16_bf16(a, bv, Ct[di], 0, 0, 0);
        }
        __builtin_amdgcn_sched_barrier(0);
      }
      __syncthreads();
    }
  }
}

__device__ __forceinline__ void hyconv_item(const Params& p, int c, char* smem, bool dry) {
  const bf16_t* UT = (const bf16_t*)(p.ws + OFF_UHY);
  bf16_t* GT = (bf16_t*)(p.ws + OFF_GHY);
  const float* KERNT = (const float*)(p.ws + OFF_KERN) + (size_t)c * 4096;
  uint4* Vt = (uint4*)smem;
  bf16_t* KTs = (bf16_t*)(smem + 65536);
  const int tid = opaque_tid(), lane = tid & 63, w = tid >> 6;
  const int fr = lane & 31, fh = lane >> 5;
  __syncthreads();
  if (tid < 8) KTs[tid] = 0;
#pragma unroll 4
  for (int m = tid; m < 4096; m += NTHREADS) KTs[8 + m] = f2bf(KERNT[m]);
  __syncthreads();
#pragma unroll 2
  for (int m = tid; m < 4096; m += NTHREADS) {
    uint4 v;
    v.x = (unsigned)KTs[8 + m] | ((unsigned)KTs[8 + m - 1] << 16);
    v.y = (unsigned)KTs[8 + m - 2] | ((unsigned)KTs[8 + m - 3] << 16);
    v.z = (unsigned)KTs[8 + m - 4] | ((unsigned)KTs[8 + m - 5] << 16);
    v.w = (unsigned)KTs[8 + m - 6] | ((unsigned)KTs[8 + m - 7] << 16);
    Vt[m] = v;
  }
  __syncthreads();
  const float bc = p.in[36][c];
  const bf16_t* ub = UT + ((size_t)c * 32 + fr) * 2048 + 8 * fh;
#pragma unroll 1
  for (int tg = 0; tg < 4; ++tg) {
    const int t0g = w * 512 + tg * 128;
    f32x16 acc[4];
#pragma unroll
    for (int q = 0; q < 4; ++q)
#pragma unroll
      for (int r = 0; r < 16; ++r) acc[q][r] = 0.f;
    const int mbase = t0g + fr - 8 * fh + 2048;
#pragma unroll 8
    for (int s0 = 0; s0 < 2048; s0 += 16) {
      const bf16x8 bfrag = *(const bf16x8*)(ub + s0);
#pragma unroll
      for (int q = 0; q < 4; ++q) {
        const bf16x8 a = *(const bf16x8*)(Vt + (mbase + q * 32 - s0));
        acc[q] = __builtin_amdgcn_mfma_f32_32x32x16_bf16(a, bfrag, acc[q], 0, 0, 0);
      }
    }
#pragma unroll
    for (int q = 0; q < 4; ++q)
#pragma unroll
      for (int g4 = 0; g4 < 4; ++g4) {
        const int t = t0g + q * 32 + 8 * g4 + 4 * fh;
        const size_t idx = ((size_t)c * 32 + fr) * 2048 + t;
        const uint2 gu = *(const uint2*)(GT + idx);
        const uint2 uu = *(const uint2*)(UT + idx);
        float gv[4], uv[4], o[4];
        gv[0] = __uint_as_float(gu.x << 16); gv[1] = __uint_as_float(gu.x & 0xffff0000u);
        gv[2] = __uint_as_float(gu.y << 16); gv[3] = __uint_as_float(gu.y & 0xffff0000u);
        uv[0] = __uint_as_float(uu.x << 16); uv[1] = __uint_as_float(uu.x & 0xffff0000u);
        uv[2] = __uint_as_float(uu.y << 16); uv[3] = __uint_as_float(uu.y & 0xffff0000u);
#pragma unroll
        for (int i = 0; i < 4; ++i) o[i] = gv[i] * (acc[q][4 * g4 + i] + bc * uv[i]);
        uint2 pk;
        pk.x = (unsigned)f2bf(o[0]) | ((unsigned)f2bf(o[1]) << 16);
        pk.y = (unsigned)f2bf(o[2]) | ((unsigned)f2bf(o[3]) << 16);
        if (!dry) *(uint2*)(GT + idx) = pk;
      }
  }
  __syncthreads();
}

__device__ __forceinline__ void phase_scan1(const Params& p, char* smem, int* s_item, int rep) {
  int* ctr = (int*)(p.ws + OFF_MISC + 4096) + 1 + 2 * rep;
  for (;;) {
    const int item = next_item(ctr, s_item);
    if (item >= 256 + 512) break;
    if (item < 256) hgrn_chain(p, item, smem);
    else hyconv_item(p, item - 256, smem, (PROBE_PHASE == 9) && rep == 0 && p.ph_hi == 13);
  }
}

__device__ __forceinline__ void phase_finish1(const Params& p, char* smem) {
  const int lane = threadIdx.x & 63, wave = threadIdx.x >> 6;
  const bf16_t* U = (const bf16_t*)(p.ws + OFF_RU);
  bf16_t* g0 = (bf16_t*)(p.ws + OFF_RH);
  const bf16_t* g1 = g0 + (size_t)NLAT * 512;
  const float* gng = p.in[28];
  const int c0 = lane * 8;
  for (int row = blockIdx.x * 4 + wave; row < NLAT; row += gridDim.x * 4) {
    float a[8], bb[8], z[8], y[8];
    ld8(g0 + (size_t)row * 512 + c0, a);
    ld8(g1 + (size_t)row * 512 + c0, bb);
    ld8(U + (size_t)row * LDU1 + C_GZ + c0, z);
    float ss = 0.f;
#pragma unroll
    for (int i = 0; i < 8; ++i) { a[i] += bb[i]; ss += a[i] * a[i]; }
#pragma unroll
    for (int of = 1; of < 16; of <<= 1) ss += __shfl_xor(ss, of, 64);
    const float rstd = rsqrtf(ss * (1.0f / 128.0f) + 1e-6f);
#pragma unroll
    for (int i = 0; i < 8; ++i) y[i] = a[i] * rstd * gng[c0 + i] * siluf_(z[i]);
    st8(g0 + (size_t)row * 512 + kswz(row, c0), y);
  }
  {
    const bf16_t* YT = (const bf16_t*)(p.ws + OFF_GHY);
    bf16_t* Yo = (bf16_t*)(p.ws + OFF_UHY);
    bf16_t* Tt = (bf16_t*)smem;
    const int tid = opaque_tid();
    for (int item = blockIdx.x; item < 8192; item += gridDim.x) {
      const int ct = item & 7, tt = (item >> 3) & 31, b = item >> 8;
      const int t0 = tt * 64;
      __syncthreads();
      {
        const int cl = tid >> 2, part = tid & 3;
        const size_t src = ((size_t)(ct * 64 + cl) * 32 + b) * 2048 + t0 + part * 16;
        *(uint4*)(Tt + cl * 72 + part * 16) = *(const uint4*)(YT + src);
        *(uint4*)(Tt + cl * 72 + part * 16 + 8) = *(const uint4*)(YT + src + 8);
      }
      __syncthreads();
      {
        const int tk = tid >> 2, cq = tid & 3;
        unsigned pk[8];
#pragma unroll
        for (int i = 0; i < 8; ++i)
          pk[i] = (unsigned)Tt[(cq * 16 + 2 * i) * 72 + tk] | ((unsigned)Tt[(cq * 16 + 2 * i + 1) * 72 + tk] << 16);
        bf16_t* dst = Yo + (size_t)(b * 2048 + t0 + tk) * 512 + kswz(b * 2048 + t0 + tk, ct * 64) + cq * 16;
        *(uint4*)dst = make_uint4(pk[0], pk[1], pk[2], pk[3]);
        *(uint4*)(dst + 8) = make_uint4(pk[4], pk[5], pk[6], pk[7]);
      }
    }
    __syncthreads();
  }
}

__device__ __forceinline__ void phase_final(const Params& p) {
  const int lane = threadIdx.x & 63, wave = threadIdx.x >> 6;
  const float* g = p.in[37];
  for (int row = blockIdx.x * 4 + wave; row < NLAT; row += gridDim.x * 4) {
    float* src = p.out + (size_t)row * 1024;
    float4 v[4];
    float ss = 0.f;
#pragma unroll
    for (int i = 0; i < 4; ++i) {
      v[i] = *(const float4*)(src + i * 256 + lane * 4);
      ss += v[i].x * v[i].x + v[i].y * v[i].y + v[i].z * v[i].z + v[i].w * v[i].w;
    }
    ss = wave_sum(ss);
    const float rstd = rsqrtf(ss * (1.0f / 1024.0f) + 1e-6f);
#pragma unroll
    for (int i = 0; i < 4; ++i) {
      const int c = i * 256 + lane * 4;
      const float4 gg = *(const float4*)(g + c);
      float4 o;
      o.x = v[i].x * rstd * gg.x; o.y = v[i].y * rstd * gg.y; o.z = v[i].z * rstd * gg.z; o.w = v[i].w * rstd * gg.w;
      *(float4*)(src + c) = o;
    }
  }
}

#define NPHASES 13
__global__ void __launch_bounds__(NTHREADS, 2) mega_kernel(Params p) {
  __shared__ __attribute__((aligned(16))) char smem[SMEM_BYTES];
  __shared__ int s_item;
  cg::grid_group grid = cg::this_grid();
  unsigned* bar_ctr = (unsigned*)(p.ws + OFF_MISC + 12288);
  unsigned bar_idx = 0;
  bool first_bar = true;
#define GRID_BAR() { if (first_bar) { grid.sync(); first_bar = false; } else { ++bar_idx; fast_grid_barrier(bar_ctr, bar_idx); } }
#define PH_BEGIN(n) if (p.ph_lo <= (n) && (n) < p.ph_hi) { if ((n) > p.ph_lo) GRID_BAR() for (int rep = 0; rep < ((n) == PROBE_PHASE ? 2 : 1); ++rep) { if (rep) GRID_BAR()
#define PH_END }}
  PH_BEGIN(0) phase_setup(p, smem); PH_END
  PH_BEGIN(1) phase_h(p, 0); phase_fnorm(p, smem); PH_END
  PH_BEGIN(2)
    phase_kern(p);
    EpiStoreBf16 epi{(bf16_t*)(p.ws + OFF_RU), LDU0, LDU0};
    const bf16_t* A = (const bf16_t*)(p.ws + OFF_RH);
    gemm_tiles(A, 1024, A + 512, 1024, (const bf16_t*)(p.ws + OFF_WIN0T), NTOK / 256, 39, epi, smem);
  PH_END
  PH_BEGIN(3) phase_scan0(p, smem, &s_item, rep); PH_END
  PH_BEGIN(4) phase_finish0(p); PH_END
  PH_BEGIN(5)
    EpiOut0 epi{p.in[0], p.in[2], (const float*)(p.ws + OFF_MOD), p.out, (float*)(p.ws + OFF_XC1)};
    const bf16_t* A = (const bf16_t*)(p.ws + OFF_RH);
    gemm_tiles(A, 1024, A + 512, 1024, (const bf16_t*)(p.ws + OFF_WOUT0T), NTOK / 256, 8, epi, smem);
  PH_END
  PH_BEGIN(6) phase_h(p, 1); PH_END
  PH_BEGIN(7)
    EpiStoreBf16 epi{(bf16_t*)(p.ws + OFF_RU), LDU1, LDU1};
    const bf16_t* A = (const bf16_t*)(p.ws + OFF_RH);
    gemm_tiles(A, 1024, A + 512, 1024, (const bf16_t*)(p.ws + OFF_WIN1T), NTOK / 256, 36, epi, smem, NLAT / 256, 20);
  PH_END
  PH_BEGIN(8) phase_hyprep(p, smem); PH_END
  PH_BEGIN(9) phase_scan1(p, smem, &s_item, rep); PH_END
  PH_BEGIN(10) phase_finish1(p, smem); PH_END
  PH_BEGIN(11)
    EpiOut1 epi{(const float*)(p.ws + OFF_MOD) + 33 * 3072, p.out};
    gemm_tiles((const bf16_t*)(p.ws + OFF_RH), 512, (const bf16_t*)(p.ws + OFF_UHY), 512,
               (const bf16_t*)(p.ws + OFF_WOUT1T), NLAT / 256, 8, epi, smem);
  PH_END
  PH_BEGIN(12) phase_final(p); PH_END
}

#ifndef MULTI_LAUNCH
#define MULTI_LAUNCH 0
#endif

extern "C" void kernel_launch(void* const* d_in, const int* in_sizes, int n_in, void* d_out, int out_size, void* d_ws, size_t ws_size,
                              hipStream_t stream) {
  static int grid_blocks = 0;
  if (!grid_blocks) {
    int dev = 0, cus = 0, per_cu = 0;
    hipGetDevice(&dev);
    hipDeviceGetAttribute(&cus, hipDeviceAttributeMultiprocessorCount, dev);
    hipOccupancyMaxActiveBlocksPerMultiprocessor(&per_cu, (const void*)mega_kernel, NTHREADS, 0);
    if (per_cu > 2) per_cu = 2;
    if (per_cu < 1) per_cu = 1;
    grid_blocks = cus * per_cu;
    if (ws_size < WS_NEED) fprintf(stderr, "kernel_launch: workspace too small: %zu < %zu\n", ws_size, (size_t)WS_NEED);
    if (n_in != 38) fprintf(stderr, "kernel_launch: expected 38 inputs, got %d\n", n_in);
  }
  Params p{};
  for (int i = 0; i < 38; ++i) p.in[i] = (const float*)d_in[i];
  p.out = (float*)d_out;
  p.ws = (char*)d_ws;
#if MULTI_LAUNCH
  for (int ph = 0; ph < NPHASES; ++ph) {
    p.ph_lo = ph; p.ph_hi = ph + 1;
    hipLaunchKernelGGL(mega_kernel, dim3(grid_blocks), dim3(NTHREADS), 0, stream, p);
  }
#else
  p.ph_lo = 0; p.ph_hi = NPHASES;
  void* args[] = {&p};
  hipError_t e = hipLaunchCooperativeKernel((const void*)mega_kernel, dim3(grid_blocks), dim3(NTHREADS), args, 0, stream);
  if (e != hipSuccess) fprintf(stderr, "cooperative launch failed: %s (grid %d)\n", hipGetErrorString(e), grid_blocks);
#endif
}
```
